# Optimizing an MI355X kernel written in HIP

```python
import math
import jax
import jax.numpy as jnp
from jax import lax
import numpy as np

D_MODEL = 1024
BATCH = 4
SEQ = 8192
DEPTH = 2

CTX_LEN = 256
GRID_W = 64
HEAD_DIM = 64
BRANCH_W = D_MODEL // 2

ATT_HEADS = BRANCH_W // HEAD_DIM
ATT_KV_HEADS = 2
ATT_GROUP = ATT_HEADS // ATT_KV_HEADS
WINDOW = 128
BLOCK = 128
ROPE_BASE = 10000.0
NEG_INF = -1e30

RWKV_HEADS = BRANCH_W // HEAD_DIM
RWKV_W = RWKV_HEADS * HEAD_DIM
W_LORA = 64
A_LORA = 64
G_LORA = 128
DECAY_SCALE = 0.606531
GN_EPS = 64e-5

S5_W = BRANCH_W
S5_GROUP_CH = 16
S5_GROUPS = S5_W // S5_GROUP_CH
S5_STATE = 64

D_FF = 2816
FFN_RES = 0.5
N_BRANCH = 3
N_MOD = 9
ALPHA = (2.0 * DEPTH) ** 0.25
BETA = (8.0 * DEPTH) ** -0.25
LN_EPS = 1e-6

ATT_Q = ATT_HEADS * HEAD_DIM
ATT_KV = ATT_KV_HEADS * HEAD_DIM
ATT_IN = ATT_Q + 2 * ATT_KV
RWKV_IN = 3 * RWKV_W + 2 * W_LORA + A_LORA + G_LORA
N_IN = ATT_IN + RWKV_IN + S5_W + N_BRANCH * D_MODEL

F32 = jnp.float32

kernel_name = 'hybrid_dit_gqa_rwkv7_s5_block'


def _normalise(x):
    xf = x.astype(F32)
    mean = jnp.mean(xf, -1, keepdims=True)
    var = jnp.mean(jnp.square(xf - mean), -1, keepdims=True)
    return (xf - mean) * lax.rsqrt(var + LN_EPS)


def ln_plain(x):
    return _normalise(x).astype(x.dtype)


def ln_affine(x, g, b):
    return (_normalise(x) * g.astype(F32) + b.astype(F32)).astype(x.dtype)


def modulate(x, shift, scale):
    return ln_plain(x) * (1.0 + scale) + shift


def swiglu(u, w1, w2):
    gate, up = jnp.split(u @ w1, 2, axis=-1)
    return (jax.nn.silu(gate) * up) @ w2


def ffn_sublayer(x, shift, scale, gate, w1, w2, g, b):
    h = swiglu(modulate(x, shift, scale), w1, w2)
    return ln_affine(ALPHA * x + FFN_RES * gate * h, g, b)


def centred_shift(z):
    zp = jnp.pad(z, ((0, 0), (1, 1), (0, 0)))
    return 0.5 * (zp[:, :-2] + zp[:, 2:])


def rope_1d(x, pos):
    n = x.shape[-1] // 2
    inv = ROPE_BASE ** (-jnp.arange(n, dtype=F32) / n)
    ang = pos.astype(F32)[:, None] * inv[None, :]
    shape = (pos.shape[0],) + (1,) * (x.ndim - 3) + (n,)
    cos = jnp.cos(ang).reshape(shape)
    sin = jnp.sin(ang).reshape(shape)
    xf = x.astype(F32)
    x1, x2 = xf[..., :n], xf[..., n:]
    return jnp.concatenate([x1 * cos - x2 * sin, x2 * cos + x1 * sin], axis=-1).astype(x.dtype)


def axial_rope(x, row, col):
    h = HEAD_DIM // 2
    return jnp.concatenate([rope_1d(x[..., :h], row), rope_1d(x[..., h:], col)], axis=-1)


def attention_branch(zl, zc, sink, row, col, ctx_out):
    bsz, t_len = zl.shape[:2]
    c_len = zc.shape[1]
    nb = t_len // BLOCK
    scale = HEAD_DIM ** -0.5

    def split_heads(z):
        q, k, v = jnp.split(z, [ATT_Q, ATT_Q + ATT_KV], axis=-1)
        lead = z.shape[:2]
        return (q.reshape(lead + (ATT_KV_HEADS, ATT_GROUP, HEAD_DIM)),
                k.reshape(lead + (ATT_KV_HEADS, HEAD_DIM)),
                v.reshape(lead + (ATT_KV_HEADS, HEAD_DIM)))

    ql, kl, vl = split_heads(zl)
    qc, kc, vc = split_heads(zc)
    ql = axial_rope(ql, row, col)
    kl = axial_rope(kl, row, col)

    def band(t):
        tp = jnp.pad(t, ((0, 0), (BLOCK, BLOCK), (0, 0), (0, 0)))
        tp = tp.reshape(bsz, nb + 2, BLOCK, ATT_KV_HEADS, HEAD_DIM)
        return jnp.concatenate([tp[:, :-2], tp[:, 1:-1], tp[:, 2:]], axis=2)

    qb = ql.reshape(bsz, nb, BLOCK, ATT_KV_HEADS, ATT_GROUP, HEAD_DIM)
    kb, vb = band(kl), band(vl)
    s_loc = jnp.einsum('bnqhgd,bnkhd->bhgnqk', qb, kb).astype(F32) * scale
    q_off = jnp.arange(BLOCK)[:, None]
    k_off = jnp.arange(3 * BLOCK)[None, :]
    k_pos = jnp.arange(nb)[:, None, None] * BLOCK + k_off[None] - BLOCK
    mask = (jnp.abs(k_off - BLOCK - q_off) <= WINDOW)[None] & (k_pos >= 0) & (k_pos < t_len)
    s_loc = jnp.where(mask, s_loc, NEG_INF)
    s_ctx = jnp.einsum('bnqhgd,bchd->bhgnqc', qb, kc).astype(F32) * scale
    sink_f = sink.astype(F32).reshape(1, ATT_KV_HEADS, ATT_GROUP, 1, 1, 1)
    s_sink = jnp.broadcast_to(sink_f, s_loc.shape[:-1] + (1,))
    p = jax.nn.softmax(jnp.concatenate([s_loc, s_ctx, s_sink], axis=-1), axis=-1)
    p_loc = p[..., :3 * BLOCK].astype(vb.dtype)
    p_ctx = p[..., 3 * BLOCK:3 * BLOCK + c_len].astype(vc.dtype)
    ol = (jnp.einsum('bhgnqk,bnkhd->bnqhgd', p_loc, vb)
          + jnp.einsum('bhgnqc,bchd->bnqhgd', p_ctx, vc))
    yl = ol.reshape(bsz, t_len, ATT_Q)
    yc = None
    if ctx_out:
        sc = jnp.einsum('bchgd,bkhd->bhgck', qc, kc).astype(F32) * scale
        sc_sink = jnp.broadcast_to(sink_f[..., 0], sc.shape[:-1] + (1,))
        pc = jax.nn.softmax(jnp.concatenate([sc, sc_sink], axis=-1), axis=-1)[..., :c_len]
        yc = jnp.einsum('bhgck,bkhd->bchgd', pc.astype(vc.dtype), vc).reshape(bsz, c_len, ATT_Q)
    return yl, yc


def rwkv7_scan(state0, r, decay, k, v, kk, kka, reverse):
    def step(state, inp):
        r_t, w_t, k_t, v_t, kk_t, b_t = inp
        state = (state * w_t[:, :, None, :]
                 - jnp.einsum('bhvk,bhk->bhv', state, kk_t)[..., None] * b_t[:, :, None, :]
                 + v_t[..., None] * k_t[:, :, None, :])
        return state, jnp.einsum('bhvk,bhk->bhv', state, r_t)

    xs = tuple(jnp.swapaxes(t, 0, 1) for t in (r, decay, k, v, kk, kka))
    state, out = lax.scan(step, state0, xs, reverse=reverse)
    return state, jnp.swapaxes(out, 0, 1)


def rwkv_branch(zl, zc, mu, w0, w2, a0, a2, g2, k_k, k_a, r_k, gn_g, gn_b, ctx_out):
    cuts = [RWKV_W, 2 * RWKV_W, 3 * RWKV_W, 3 * RWKV_W + 2 * W_LORA,
            3 * RWKV_W + 2 * W_LORA + A_LORA]
    mu_f, w0_f, w2_f = mu.astype(F32), w0.astype(F32), w2.astype(F32)
    a0_f, a2_f, g2_f = a0.astype(F32), a2.astype(F32), g2.astype(F32)
    kk_f, ka_f, rk_f = k_k.astype(F32), k_a.astype(F32), r_k.astype(F32)
    gng_f, gnb_f = gn_g.astype(F32), gn_b.astype(F32)

    def prepare(z):
        bsz, t_len = z.shape[:2]
        zf = z.astype(F32)
        zf = zf + mu_f * (centred_shift(zf) - zf)
        r, k, v, w_lo, a_lo, g_lo = jnp.split(zf, cuts, axis=-1)
        heads = lambda t: t.reshape(bsz, t_len, RWKV_HEADS, HEAD_DIM)
        w_lo = w_lo.reshape(bsz, t_len, 2, W_LORA)
        decay = jnp.exp(-DECAY_SCALE * jax.nn.sigmoid(
            w0_f + jnp.einsum('btdr,drc->btdc', jnp.tanh(w_lo), w2_f)))
        a = jax.nn.sigmoid(a0_f + a_lo @ a2_f)
        g = jax.nn.sigmoid(g_lo) @ g2_f
        kk = heads(k * kk_f)
        kk = kk * lax.rsqrt(jnp.sum(jnp.square(kk), -1, keepdims=True) + 1e-12)
        k = k * (1.0 + (a - 1.0) * ka_f)
        return (heads(r), heads(decay[:, :, 0]), heads(decay[:, :, 1]), heads(k), heads(v),
                kk, kk * heads(a), g)

    def finish(o, r, k, v, g, dtype):
        bsz, t_len = o.shape[:2]
        mean = jnp.mean(o, -1, keepdims=True)
        var = jnp.mean(jnp.square(o - mean), -1, keepdims=True)
        on = ((o - mean) * lax.rsqrt(var + GN_EPS)).reshape(bsz, t_len, RWKV_W) * gng_f + gnb_f
        bonus = (jnp.sum(r * k * rk_f, -1, keepdims=True) * v).reshape(bsz, t_len, RWKV_W)
        return ((on + bonus) * g).astype(dtype)

    rc, dfc, dbc, kc, vc, kkc, bc, gc = prepare(zc)
    rl, dfl, dbl, kl, vl, kkl, bl, gl = prepare(zl)
    zero = jnp.zeros((zc.shape[0], RWKV_HEADS, HEAD_DIM, HEAD_DIM), F32)
    s_f, ocf = rwkv7_scan(zero, rc, dfc, kc, vc, kkc, bc, reverse=False)
    s_b, ocb = rwkv7_scan(zero, rc, dbc, kc, vc, kkc, bc, reverse=True)
    _, olf = rwkv7_scan(s_f, rl, dfl, kl, vl, kkl, bl, reverse=False)
    _, olb = rwkv7_scan(s_b, rl, dbl, kl, vl, kkl, bl, reverse=True)
    yl = finish(olf + olb, rl, kl, vl, gl, zl.dtype)
    yc = finish(ocf + ocb, rc, kc, vc, gc, zc.dtype) if ctx_out else None
    return yl, yc


def s5_discretise(a_re, a_im, log_step, b_re, b_im):
    a_re, a_im = a_re.astype(F32), a_im.astype(F32)
    dt = jnp.exp(log_step.astype(F32))[:, None]
    mag = jnp.exp(a_re * dt)
    lr, li = mag * jnp.cos(a_im * dt), mag * jnp.sin(a_im * dt)
    den = jnp.square(a_re) + jnp.square(a_im)
    cr = ((lr - 1.0) * a_re + li * a_im) / den
    ci = (li * a_re - (lr - 1.0) * a_im) / den
    br, bi = b_re.astype(F32), b_im.astype(F32)
    bbr = cr[..., None] * br - ci[..., None] * bi
    bbi = cr[..., None] * bi + ci[..., None] * br
    return lr, li, bbr, bbi


def s5_combine(e1, e2):
    a1r, a1i, b1r, b1i = e1
    a2r, a2i, b2r, b2i = e2
    return (a2r * a1r - a2i * a1i, a2r * a1i + a2i * a1r,
            a2r * b1r - a2i * b1i + b2r, a2r * b1i + a2i * b1r + b2i)


def s5_scan_fwd(lr, li, br, bi, h0r, h0i):
    br = br.at[:, 0].add(lr * h0r - li * h0i)
    bi = bi.at[:, 0].add(lr * h0i + li * h0r)
    shape = (1, br.shape[1]) + lr.shape
    ar = jnp.broadcast_to(lr, shape)
    ai = jnp.broadcast_to(li, shape)
    _, _, xr, xi = lax.associative_scan(s5_combine, (ar, ai, br, bi), axis=1)
    return xr, xi


def s5_scan_bwd(lr, li, br, bi, h0r, h0i):
    xr, xi = s5_scan_fwd(lr, li, jnp.flip(br, 1), jnp.flip(bi, 1), h0r, h0i)
    return jnp.flip(xr, 1), jnp.flip(xi, 1)


def s5_branch(ul, uc, a_re, a_im, log_step, b_re, b_im, c_re, c_im, d, glu_w, glu_b, ctx_out):
    fwd = s5_discretise(a_re[0], a_im[0], log_step[0], b_re, b_im)
    bwd = s5_discretise(a_re[1], a_im[1], log_step[1], b_re, b_im)
    cr, ci = c_re.astype(F32), c_im.astype(F32)

    def drive(u, disc):
        ug = u.astype(F32).reshape(u.shape[:2] + (S5_GROUPS, S5_GROUP_CH))
        return (jnp.einsum('btgc,gpc->btgp', ug, disc[2]),
                jnp.einsum('btgc,gpc->btgp', ug, disc[3]))

    def read(xr, xi):
        return jnp.einsum('btgp,gcp->btgc', xr, cr) - jnp.einsum('btgp,gcp->btgc', xi, ci)

    def finish(u, y):
        y = y.reshape(u.shape[:2] + (S5_W,)) + d.astype(F32) * u.astype(F32)
        y = jax.nn.gelu(y)
        return (y * jax.nn.sigmoid(y @ glu_w.astype(F32) + glu_b.astype(F32))).astype(u.dtype)

    zero = jnp.zeros((uc.shape[0], S5_GROUPS, S5_STATE), F32)
    xcf = s5_scan_fwd(fwd[0], fwd[1], *drive(uc, fwd), zero, zero)
    xcb = s5_scan_bwd(bwd[0], bwd[1], *drive(uc, bwd), zero, zero)
    ylf = read(*s5_scan_fwd(fwd[0], fwd[1], *drive(ul, fwd), xcf[0][:, -1], xcf[1][:, -1]))
    ylb = read(*s5_scan_bwd(bwd[0], bwd[1], *drive(ul, bwd), xcb[0][:, 0], xcb[1][:, 0]))
    yl = finish(ul, ylf + ylb)
    yc = finish(uc, read(*xcf) + read(*xcb)) if ctx_out else None
    return yl, yc


def gated_merge(z_gate, ya, yr, ys, branch_proj, w_out):
    ga, gr, gs = jnp.split(jax.nn.sigmoid(z_gate), N_BRANCH, axis=-1)
    m = ga * (ya @ branch_proj[0]) + gr * (yr @ branch_proj[1]) + gs * (ys @ branch_proj[2])
    return m @ w_out


def mixer_sublayer(ul, uc, row, col, ctx_out, w_in, attn_sink, rwkv_mu, rwkv_w0, rwkv_w2,
                   rwkv_a0, rwkv_a2, rwkv_g2, rwkv_k_k, rwkv_k_a, rwkv_r_k, rwkv_gn_g, rwkv_gn_b,
                   s5_a_re, s5_a_im, s5_log_step, s5_b_re, s5_b_im, s5_c_re, s5_c_im, s5_d,
                   s5_glu_w, s5_glu_b, branch_proj, w_out):
    cuts = [ATT_IN, ATT_IN + RWKV_IN, ATT_IN + RWKV_IN + S5_W]
    za_l, zr_l, zs_l, zg_l = jnp.split(ul @ w_in, cuts, axis=-1)
    za_c, zr_c, zs_c, zg_c = jnp.split(uc @ w_in, cuts, axis=-1)
    ya_l, ya_c = attention_branch(za_l, za_c, attn_sink, row, col, ctx_out)
    yr_l, yr_c = rwkv_branch(zr_l, zr_c, rwkv_mu, rwkv_w0, rwkv_w2, rwkv_a0, rwkv_a2, rwkv_g2,
                             rwkv_k_k, rwkv_k_a, rwkv_r_k, rwkv_gn_g, rwkv_gn_b, ctx_out)
    ys_l, ys_c = s5_branch(zs_l, zs_c, s5_a_re, s5_a_im, s5_log_step, s5_b_re, s5_b_im,
                           s5_c_re, s5_c_im, s5_d, s5_glu_w, s5_glu_b, ctx_out)
    out_l = gated_merge(zg_l, ya_l, yr_l, ys_l, branch_proj, w_out)
    out_c = gated_merge(zg_c, ya_c, yr_c, ys_c, branch_proj, w_out) if ctx_out else None
    return out_l, out_c


def setup_inputs(seed: int = 0) -> dict:
    key = jax.random.key(seed)
    keys = jax.random.split(key, 40)

    def nrm(i, shape, scale):
        return scale * jax.random.normal(keys[i], shape, F32)

    def uni(i, shape, lo, hi):
        return jax.random.uniform(keys[i], shape, F32, lo, hi)

    D = D_MODEL
    L = DEPTH
    n_idx = jnp.arange(S5_STATE, dtype=F32)
    s5_shape = (L, 2, S5_GROUPS, S5_STATE)
    return {
        'x': nrm(0, (BATCH, SEQ, D), 1.0),
        'c': nrm(1, (BATCH, D), 1.0),
        'ctx': nrm(2, (BATCH, CTX_LEN, D), 1.0),
        'c_ctx': nrm(3, (D,), 1.0),
        'w_ada': nrm(4, (L, D, N_MOD * D), 0.5 * D ** -0.5),
        'b_ada': nrm(5, (L, N_MOD * D), 0.02),
        'ln_g': 1.0 + nrm(6, (L, 3, D), 0.05),
        'ln_b': nrm(7, (L, 3, D), 0.02),
        'ffn_w_in': nrm(8, (L, 2, D, 2 * D_FF), D ** -0.5),
        'ffn_w_out': nrm(9, (L, 2, D_FF, D), BETA * D_FF ** -0.5),
        'w_in': nrm(10, (L, D, N_IN), D ** -0.5),
        'attn_sink': nrm(11, (L, ATT_HEADS), 0.5),
        'rwkv_mu': uni(12, (L, RWKV_IN), 0.0, 1.0),
        'rwkv_w0': uni(13, (L, 2, RWKV_W), -2.0, 2.0),
        'rwkv_w2': nrm(14, (L, 2, W_LORA, RWKV_W), 0.5 * W_LORA ** -0.5),
        'rwkv_a0': nrm(15, (L, RWKV_W), 0.1),
        'rwkv_a2': nrm(16, (L, A_LORA, RWKV_W), 0.5 * A_LORA ** -0.5),
        'rwkv_g2': nrm(17, (L, G_LORA, RWKV_W), G_LORA ** -0.5),
        'rwkv_k_k': 0.85 + nrm(18, (L, RWKV_W), 0.05),
        'rwkv_k_a': 1.0 + nrm(19, (L, RWKV_W), 0.05),
        'rwkv_r_k': nrm(20, (L, RWKV_HEADS, HEAD_DIM), 0.1),
        'rwkv_gn_g': 1.0 + nrm(21, (L, RWKV_W), 0.05),
        'rwkv_gn_b': nrm(22, (L, RWKV_W), 0.02),
        's5_a_re': -0.5 * jnp.exp(nrm(23, s5_shape, 0.05)),
        's5_a_im': math.pi * n_idx + nrm(24, s5_shape, 0.01),
        's5_log_step': uni(25, (L, 2, S5_GROUPS), math.log(1e-3), math.log(1e-1)),
        's5_b_re': nrm(26, (L, S5_GROUPS, S5_STATE, S5_GROUP_CH), (2.0 * S5_GROUP_CH) ** -0.5),
        's5_b_im': nrm(27, (L, S5_GROUPS, S5_STATE, S5_GROUP_CH), (2.0 * S5_GROUP_CH) ** -0.5),
        's5_c_re': nrm(28, (L, S5_GROUPS, S5_GROUP_CH, S5_STATE), S5_STATE ** -0.5),
        's5_c_im': nrm(29, (L, S5_GROUPS, S5_GROUP_CH, S5_STATE), S5_STATE ** -0.5),
        's5_d': nrm(30, (L, S5_W), 1.0),
        's5_glu_w': nrm(31, (L, S5_W, S5_W), S5_W ** -0.5),
        's5_glu_b': nrm(32, (L, S5_W), 0.02),
        'branch_proj': nrm(33, (L, N_BRANCH, BRANCH_W, D), BRANCH_W ** -0.5),
        'w_out': nrm(34, (L, D, D), BETA * D ** -0.5),
    }


def reference(x, c, ctx, c_ctx, w_ada, b_ada, ln_g, ln_b, ffn_w_in, ffn_w_out, w_in, attn_sink,
              rwkv_mu, rwkv_w0, rwkv_w2, rwkv_a0, rwkv_a2, rwkv_g2, rwkv_k_k, rwkv_k_a, rwkv_r_k,
              rwkv_gn_g, rwkv_gn_b, s5_a_re, s5_a_im, s5_log_step, s5_b_re, s5_b_im, s5_c_re,
              s5_c_im, s5_d, s5_glu_w, s5_glu_b, branch_proj, w_out):
    t_len = x.shape[1]
    rows = t_len // GRID_W
    row = jnp.repeat(jnp.arange(rows, dtype=jnp.int32), GRID_W)
    col = jnp.tile(jnp.arange(GRID_W, dtype=jnp.int32), rows)
    cond_l = jax.nn.silu(c)
    cond_c = jax.nn.silu(c_ctx)
    xl, xc = x, ctx
    for l in range(DEPTH):
        ctx_out = l < DEPTH - 1
        ml = jnp.split((cond_l @ w_ada[l] + b_ada[l])[:, None, :], N_MOD, axis=-1)
        mc = jnp.split(cond_c @ w_ada[l] + b_ada[l], N_MOD, axis=-1)
        xl = ffn_sublayer(xl, ml[0], ml[1], ml[2], ffn_w_in[l, 0], ffn_w_out[l, 0], ln_g[l, 0], ln_b[l, 0])
        xc = ffn_sublayer(xc, mc[0], mc[1], mc[2], ffn_w_in[l, 0], ffn_w_out[l, 0], ln_g[l, 0], ln_b[l, 0])
        yl, yc = mixer_sublayer(
            modulate(xl, ml[3], ml[4]), modulate(xc, mc[3], mc[4]), row, col, ctx_out,
            w_in[l], attn_sink[l], rwkv_mu[l], rwkv_w0[l], rwkv_w2[l], rwkv_a0[l], rwkv_a2[l],
            rwkv_g2[l], rwkv_k_k[l], rwkv_k_a[l], rwkv_r_k[l], rwkv_gn_g[l], rwkv_gn_b[l],
            s5_a_re[l], s5_a_im[l], s5_log_step[l], s5_b_re[l], s5_b_im[l], s5_c_re[l],
            s5_c_im[l], s5_d[l], s5_glu_w[l], s5_glu_b[l], branch_proj[l], w_out[l])
        xl = ln_affine(ALPHA * xl + ml[5] * yl, ln_g[l, 1], ln_b[l, 1])
        xl = ffn_sublayer(xl, ml[6], ml[7], ml[8], ffn_w_in[l, 1], ffn_w_out[l, 1], ln_g[l, 2], ln_b[l, 2])
        if ctx_out:
            xc = ln_affine(ALPHA * xc + mc[5] * yc, ln_g[l, 1], ln_b[l, 1])
            xc = ffn_sublayer(xc, mc[6], mc[7], mc[8], ffn_w_in[l, 1], ffn_w_out[l, 1], ln_g[l, 2], ln_b[l, 2])
    return xl
```

```cpp
#include <hip/hip_runtime.h>
#include <hip/hip_cooperative_groups.h>
#include <stdint.h>
#include <stdio.h>
namespace cg = cooperative_groups;

#define LAS __attribute__((address_space(3)))
#define DI __device__ __forceinline__
typedef unsigned short bf16_t;
typedef short bf16x8 __attribute__((ext_vector_type(8)));
typedef float f32x4 __attribute__((ext_vector_type(4)));
typedef float f32x2 __attribute__((ext_vector_type(2)));
typedef unsigned u32x4 __attribute__((ext_vector_type(4)));
typedef unsigned u32x2 __attribute__((ext_vector_type(2)));

#ifndef PROBE
#define PROBE 0
#endif
#ifndef ONE_LAUNCH
#define ONE_LAUNCH 1
#endif

constexpr int ML = 32768, MC = 1024, MT = 33792, DM = 1024, DFF = 2816;
constexpr float ALPHA = 1.41421356237f;
constexpr float LOG2E = 1.44269504089f;
constexpr int NPHASE = 34;

constexpr size_t S512 = (size_t)MT * 512 * 2;
constexpr size_t OFF_MODS = 0;
constexpr size_t OFF_XC = 368640;
constexpr size_t OFF_WB = OFF_XC + 4194304;
constexpr size_t WB_W1A = 0, WB_W2A = 11534336, WB_W1B = 17301504, WB_W2B = 28835840, WB_WIN = 34603008, WB_WGT = 41418752,
                 WB_BP = 47710208, WB_WOUT = 50855936, WB_GLU = 52953088, WB_LORA = 53477376, WB_END = 55050240;
constexpr size_t OFF_POOL = OFF_WB + WB_END;
constexpr size_t P0 = OFF_POOL, P1 = P0 + 2 * S512, P2 = P1 + S512, P3 = P2 + S512, P4 = P3 + 3 * S512, P5 = P4 + 3 * S512, P7 = P5 + S512, PEND = P7 + 2 * S512;
constexpr size_t OFF_U = P0, OFF_ACT = P0 + 2 * S512;
constexpr size_t OFF_AP = P0, OFF_KR = P0 + 25952256, OFF_VT = P0 + S512, OFF_ST = P0, OFF_YS = P0 + S512, OFF_YR = P0;
constexpr size_t OFF_QB = P1, OFF_ZS = P2, OFF_ZR = P3, OFF_DWF = P3, OFF_DWB = P3 + S512, OFF_DWA = P3 + 2 * S512, OFF_U2 = P3;
constexpr size_t OFF_ZF = P4, OFF_MG = P4, OFF_LIN = P5, OFF_G = P5, OFF_KVB = P7, OFF_YF = P7, OFF_YB = P7 + S512, OFF_OF = P7, OFF_OB = P7 + S512;
constexpr size_t OFF_GB = P7, OFF_H = P7;
constexpr size_t OFF_BAR = PEND;
static_assert(PEND + 16384 <= (size_t)512 * 1024 * 1024, "workspace");

struct Params {
    const float* in[35];
    float* out;
    char* ws;
};
typedef const __attribute__((address_space(4))) Params* PP;
struct Ctx { PP p; int tid, bid, nb; };
enum { I_X = 0, I_C, I_CTX, I_CCTX, I_WADA, I_BADA, I_LNG, I_LNB, I_FWIN, I_FWOUT, I_WIN, I_SINK, I_MU, I_W0, I_W2, I_A0, I_A2, I_G2, I_KK, I_KA, I_RK,
       I_GNG, I_GNB, I_SARE, I_SAIM, I_SLOG, I_SBRE, I_SBIM, I_SCRE, I_SCIM, I_SD, I_GLUW, I_GLUB, I_BP, I_WOUT };

typedef __bf16 hwbf16x2 __attribute__((ext_vector_type(2)));
DI unsigned pk2(float lo, float hi) { const f32x2 v = {lo, hi}; return __builtin_bit_cast(unsigned, __builtin_convertvector(v, hwbf16x2)); }
DI bf16_t f2bf(float f) { return (bf16_t)(pk2(f, 0.f) & 0xFFFFu); }
DI float bf2f(bf16_t b) { return __uint_as_float(((unsigned)b) << 16); }

DI float bflo(unsigned w) { return __uint_as_float(w << 16); }
DI float bfhi(unsigned w) { return __uint_as_float(w & 0xFFFF0000u); }
DI float sigm(float x) { return __builtin_amdgcn_rcpf(1.0f + __expf(-x)); }
template <int M> DI float swz(float v) { return __builtin_bit_cast(float, __builtin_amdgcn_ds_swizzle(__builtin_bit_cast(int, v), (M << 10) | 0x1f)); }
DI float wsum(float v) {
    v += swz<1>(v); v += swz<2>(v); v += swz<4>(v); v += swz<8>(v); v += swz<16>(v);
    return __builtin_bit_cast(float, __builtin_amdgcn_readlane(__builtin_bit_cast(int, v), 0)) + __builtin_bit_cast(float, __builtin_amdgcn_readlane(__builtin_bit_cast(int, v), 32));
}
template <int CTRL> DI float dppf(float x) { return __builtin_bit_cast(float, __builtin_amdgcn_mov_dpp(__builtin_bit_cast(int, x), CTRL, 0xF, 0xF, true)); }
DI float row16_allsum(float x) { x += dppf<0x128>(x); x += dppf<0x124>(x); x += dppf<0x122>(x); x += dppf<0x121>(x); return x; }
DI float rlf(float x, int l) { return __builtin_bit_cast(float, __builtin_amdgcn_readlane(__builtin_bit_cast(int, x), l)); }
DI float xor32(int lane, float v) { return __builtin_bit_cast(float, __builtin_amdgcn_ds_bpermute((lane ^ 32) << 2, __builtin_bit_cast(int, v))); }
DI float* xrow(const Ctx& cx, int r) { return r < ML ? cx.p->out + (size_t)r * DM : (float*)(cx.p->ws + OFF_XC) + (size_t)(r - ML) * DM; }
DI int tokrow(int b, int dir, int pos) {
    if (pos < 256) return ML + b * 256 + (dir ? 255 - pos : pos);
    const int t = pos - 256; return b * 8192 + (dir ? 8191 - t : t);
}
DI void wave_lds_sync() { asm volatile("s_waitcnt lgkmcnt(0)" ::: "memory"); __builtin_amdgcn_wave_barrier(); }

namespace pg8 {
constexpr int BM = 256, BK = 64, HALF = 128, HTB = HALF * BK * 2, STAGE_BYTES = 8 * HTB;
DI int lds_byte(int r, int c) { const int st = (r >> 4) * 2 + (c >> 5), rr = r & 15, cc = c & 31, ob = rr * 64 + cc * 2; return st * 1024 + (ob ^ (((ob >> 9) & 1) << 5)); }
DI void stage_rc(int b, int& R, int& C) { const int st = b / 1024, sb = b % 1024, swz = sb ^ (((sb >> 9) & 1) << 5); R = (st >> 1) * 16 + swz / 64; C = (st & 1) * 32 + (swz % 64) / 2; }
DI int perm32(int rho) { const int n = rho >> 4, i = rho & 15; return 8 * (i >> 2) + 4 * n + (i & 3); }

struct Unit { const char* A; const char* B; unsigned lda2, ldb2; int nt; int pm, pn, tag; };
DI const char* rfl_ptr(const char* p) { const unsigned long long v = (unsigned long long)p; const unsigned lo = __builtin_amdgcn_readfirstlane((unsigned)v), hi = __builtin_amdgcn_readfirstlane((unsigned)(v >> 32)); return (const char*)(((unsigned long long)hi << 32) | lo); }
DI void uniformize(Unit& u) { u.A = rfl_ptr(u.A); u.B = rfl_ptr(u.B); u.lda2 = __builtin_amdgcn_readfirstlane(u.lda2); u.ldb2 = __builtin_amdgcn_readfirstlane(u.ldb2); u.nt = __builtin_amdgcn_readfirstlane(u.nt);
    u.pm = __builtin_amdgcn_readfirstlane(u.pm); u.pn = __builtin_amdgcn_readfirstlane(u.pn); u.tag = __builtin_amdgcn_readfirstlane(u.tag); }

DI void tile_of(int wgid, int nM, int nN, int& pm, int& pn) {
    const int nwg = nM * nN; const int q = nwg / 8, r = nwg % 8, xcd = wgid % 8, off = wgid / 8;
    wgid = (xcd < r ? xcd * (q + 1) : r * (q + 1) + (xcd - r) * q) + off;
    const int nig = 8 * nN, gid = wgid / nig, fm = gid * 8, gsz = (nM - fm) < 8 ? (nM - fm) : 8;
    pm = fm + ((wgid % nig) % gsz); pn = (wgid % nig) / gsz;
}
struct PlainSched {
    const char* A; const char* B; unsigned lda2, ldb2; int nt, nM, nN, G, c;
    DI bool next(int i, Unit& u) const {
        const long L = (long)i * G + c; if (L >= (long)nM * nN) return false;
        tile_of((int)L, nM, nN, u.pm, u.pn);
        u.A = A + (size_t)u.pm * 256 * lda2; u.B = B + (size_t)u.pn * 256 * ldb2; u.lda2 = lda2; u.ldb2 = ldb2; u.nt = nt; u.tag = 0; return true;
    }
};

template <bool PERM, class Sched, class Epi>
DI void gemm_phase(const Ctx& cx, LAS unsigned char* lds, const Sched& S, const Epi& E) {
    const int tid = cx.tid, wid = __builtin_amdgcn_readfirstlane(tid >> 6), lane = tid & 63, wr = wid >> 2, wc = wid & 3, fr = lane & 15, fq = lane >> 4;
    int Rr[2], Rb[2], Cc[2];
#pragma unroll
    for (int i = 0; i < 2; ++i) { int R, C; stage_rc(tid * 16 + i * 8192, R, C); Rr[i] = R; Rb[i] = PERM ? ((R & ~31) + perm32(R & 31)) : R; Cc[i] = C * 2; }
    const size_t kstep = (size_t)(BK * 2);
    const unsigned ldsw = (unsigned)wid * 1024u;
    const int aoff = lds_byte(wr * 64 + fr, fq * 8), boff = lds_byte(wc * 32 + fr, fq * 8);
#define PG8_SA(b, h) (((b) * 2 + (h)) * HTB)
#define PG8_SB(b, h) ((4 + (b) * 2 + (h)) * HTB)
#define PG8_STAGEA(bufoff, gbase, ld2) do { _Pragma("unroll") for (int _i = 0; _i < 2; ++_i) \
        __builtin_amdgcn_global_load_lds((const unsigned*)((const char*)(gbase) + ((unsigned)Rr[_i] * (ld2) + Cc[_i])), (LAS unsigned*)(lds + (bufoff) + ldsw + _i * 8192), 16, 0, 0); } while (0)
#define PG8_STAGEB(bufoff, gbase, ld2) do { _Pragma("unroll") for (int _i = 0; _i < 2; ++_i) \
        __builtin_amdgcn_global_load_lds((const unsigned*)((const char*)(gbase) + ((unsigned)Rb[_i] * (ld2) + Cc[_i])), (LAS unsigned*)(lds + (bufoff) + ldsw + _i * 8192), 16, 0, 0); } while (0)
#define PG8_LDA(dst, b, h) do { _Pragma("unroll") for (int m = 0; m < 4; ++m) _Pragma("unroll") for (int k = 0; k < 2; ++k) dst[m][k] = *(const LAS bf16x8*)(lds + PG8_SA(b, h) + aoff + m * 2048 + k * 1024); } while (0)
#define PG8_LDB(dst, b, h) do { _Pragma("unroll") for (int n = 0; n < 2; ++n) _Pragma("unroll") for (int k = 0; k < 2; ++k) dst[n][k] = *(const LAS bf16x8*)(lds + PG8_SB(b, h) + boff + n * 2048 + k * 1024); } while (0)
#define PG8_MMA(ai, bj, At, Bt) do { __builtin_amdgcn_s_setprio(1); _Pragma("unroll") for (int m = 0; m < 4; ++m) _Pragma("unroll") for (int n = 0; n < 2; ++n) _Pragma("unroll") for (int k = 0; k < 2; ++k) \
        acc[ai][bj][m][n] = __builtin_amdgcn_mfma_f32_16x16x32_bf16(Bt[n][k], At[m][k], acc[ai][bj][m][n], 0, 0, 0); __builtin_amdgcn_s_setprio(0); } while (0)
#define PG8_WAIT_V(n) asm volatile("s_waitcnt vmcnt(" #n ")" ::: "memory")
#define PG8_WAIT_L(n) asm volatile("s_waitcnt lgkmcnt(" #n ")" ::: "memory")
#define PG8_BAR __builtin_amdgcn_s_barrier()
#define PG8_SCHED __builtin_amdgcn_sched_barrier(0)
    Unit cur, nxt; int ui = 0;
    if (!S.next(0, cur)) return;
    f32x4 acc[2][2][4][2];
#pragma unroll
    for (int a = 0; a < 2; ++a)
#pragma unroll
        for (int b = 0; b < 2; ++b)
#pragma unroll
            for (int m = 0; m < 4; ++m)
#pragma unroll
                for (int n = 0; n < 2; ++n) acc[a][b][m][n] = (f32x4){0.f, 0.f, 0.f, 0.f};
    bf16x8 At[4][2], B0[2][2], B1[2][2];
    const char* cA = cur.A; const char* cB = cur.B;
    unsigned clA = cur.lda2, clB = cur.ldb2; size_t chA = (size_t)HALF * cur.lda2, chB = (size_t)HALF * cur.ldb2;
    PG8_STAGEB(PG8_SB(0, 0), cB, clB); PG8_STAGEA(PG8_SA(0, 0), cA, clA); PG8_STAGEB(PG8_SB(0, 1), cB + chB, clB); PG8_STAGEA(PG8_SA(0, 1), cA + chA, clA);
    if (wr == 1) PG8_BAR;
    PG8_WAIT_V(4); PG8_BAR;
    PG8_STAGEB(PG8_SB(1, 0), cB + kstep, clB); PG8_STAGEA(PG8_SA(1, 0), cA + kstep, clA); PG8_STAGEB(PG8_SB(1, 1), cB + chB + kstep, clB);
    PG8_WAIT_V(6); PG8_BAR;
    for (;;) {
        const bool has_next = S.next(ui + 1, nxt);
        const char* nA = has_next ? nxt.A : cA; const char* nB = has_next ? nxt.B : cB;
        const unsigned nlda = has_next ? nxt.lda2 : cur.lda2, nldb = has_next ? nxt.ldb2 : cur.ldb2;
        const size_t nhA = (size_t)HALF * nlda, nhB = (size_t)HALF * nldb;
        const int nt = cur.nt;
        for (int t = 0; t < nt; t += 2) {
            const bool last = (t == nt - 2);
            const char* a1 = cA + (size_t)(t + 1) * kstep;
            const char* a2 = last ? nA : cA + (size_t)(t + 2) * kstep; const char* b2 = last ? nB : cB + (size_t)(t + 2) * kstep;
            const char* a3 = a2 + kstep; const char* b3 = b2 + kstep;
            const size_t hA2 = last ? nhA : chA, hB2 = last ? nhB : chB; const unsigned lA2 = last ? nlda : clA, lB2 = last ? nldb : clB;
            PG8_LDB(B0, 0, 0); PG8_SCHED; PG8_LDA(At, 0, 0); PG8_STAGEA(PG8_SA(1, 1), a1 + chA, clA);
            PG8_WAIT_L(8); PG8_BAR; PG8_WAIT_L(0); PG8_MMA(0, 0, At, B0); PG8_BAR; PG8_SCHED;
            PG8_LDB(B1, 0, 1); PG8_STAGEB(PG8_SB(0, 0), b2, lB2);
            PG8_BAR; PG8_WAIT_L(0); PG8_MMA(0, 1, At, B1); PG8_BAR;
            PG8_LDA(At, 0, 1); PG8_STAGEA(PG8_SA(0, 0), a2, lA2);
            PG8_BAR; PG8_WAIT_L(0); PG8_MMA(1, 0, At, B0); PG8_BAR; PG8_SCHED;
            PG8_STAGEB(PG8_SB(0, 1), b2 + hB2, lB2);
            PG8_WAIT_V(6); PG8_BAR; PG8_MMA(1, 1, At, B1); PG8_BAR;
            PG8_LDB(B0, 1, 0); PG8_SCHED; PG8_LDA(At, 1, 0); PG8_STAGEA(PG8_SA(0, 1), a2 + hA2, lA2);
            PG8_WAIT_L(8); PG8_BAR; PG8_WAIT_L(0); PG8_MMA(0, 0, At, B0); PG8_BAR; PG8_SCHED;
            PG8_LDB(B1, 1, 1); PG8_STAGEB(PG8_SB(1, 0), b3, lB2);
            PG8_BAR; PG8_WAIT_L(0); PG8_MMA(0, 1, At, B1); PG8_BAR;
            PG8_LDA(At, 1, 1); PG8_STAGEA(PG8_SA(1, 0), a3, lA2);
            PG8_BAR; PG8_WAIT_L(0); PG8_MMA(1, 0, At, B0); PG8_BAR; PG8_SCHED;
            PG8_STAGEB(PG8_SB(1, 1), b3 + hB2, lB2);
            PG8_WAIT_V(6); PG8_BAR; PG8_MMA(1, 1, At, B1); PG8_BAR;
        }
        E(acc, cur, wr, wc, fr, fq);
        if (!has_next) break;
#pragma unroll
        for (int a = 0; a < 2; ++a)
#pragma unroll
            for (int b = 0; b < 2; ++b)
#pragma unroll
                for (int m = 0; m < 4; ++m)
#pragma unroll
                    for (int n = 0; n < 2; ++n) acc[a][b][m][n] = (f32x4){0.f, 0.f, 0.f, 0.f};
        cur = nxt; cA = nA; cB = nB; chA = nhA; chB = nhB; clA = nlda; clB = nldb;
        ++ui;
    }
    PG8_WAIT_V(0);
    if (wr == 0) PG8_BAR;
    PG8_BAR;
#undef PG8_SA
#undef PG8_SB
#undef PG8_STAGEA
#undef PG8_STAGEB
#undef PG8_LDA
#undef PG8_LDB
#undef PG8_MMA
#undef PG8_WAIT_V
#undef PG8_WAIT_L
#undef PG8_BAR
#undef PG8_SCHED
}
}
using pg8::Unit;
typedef const f32x4 (&AccRef)[2][2][4][2];

template <bool PERM, class Epi>
DI void run_gemm(const Ctx& cx, LAS unsigned char* lds, const void* A, int lda, const void* Bt, int ldb, int M, int N, int K, const Epi& E) {
    pg8::PlainSched S; S.A = (const char*)A; S.B = (const char*)Bt; S.lda2 = lda * 2; S.ldb2 = ldb * 2; S.nt = K / 64; S.nM = M / 256; S.nN = N / 256; S.G = cx.nb; S.c = cx.bid;
    pg8::gemm_phase<PERM>(cx, lds, S, E);
}

DI void store8(bf16_t* dst, f32x4 a, f32x4 b) { u32x4 w; w.x = pk2(a[0], a[1]); w.y = pk2(a[2], a[3]); w.z = pk2(b[0], b[1]); w.w = pk2(b[2], b[3]); *(u32x4*)dst = w; }
struct EpiSwiglu {
    bf16_t* act;
    DI void operator()(AccRef acc, const Unit& u, int wr, int wc, int fr, int fq) const {
        const int row0 = u.pm * 256 + wr * 64 + fr, col0 = u.pn * 128 + wc * 32 + 8 * fq;
#pragma unroll
        for (int ai = 0; ai < 2; ++ai)
#pragma unroll
            for (int m = 0; m < 4; ++m) {
                float v[8];
#pragma unroll
                for (int n = 0; n < 2; ++n)
#pragma unroll
                    for (int j = 0; j < 4; ++j) { const float g = acc[ai][0][m][n][j], up = acc[ai][1][m][n][j]; v[n * 4 + j] = g * sigm(g) * up; }
                u32x4 w; w.x = pk2(v[0], v[1]); w.y = pk2(v[2], v[3]); w.z = pk2(v[4], v[5]); w.w = pk2(v[6], v[7]);
                *(u32x4*)(act + (size_t)(row0 + ai * 128 + m * 16) * DFF + col0) = w;
            }
    }
};
struct EpiH {
    bf16_t* h;
    DI void operator()(AccRef acc, const Unit& u, int wr, int wc, int fr, int fq) const {
        const int row0 = u.pm * 256 + wr * 64 + fr, col0 = u.pn * 256 + wc * 32 + 8 * fq;
#pragma unroll
        for (int ai = 0; ai < 2; ++ai)
#pragma unroll
            for (int m = 0; m < 4; ++m)
#pragma unroll
                for (int bj = 0; bj < 2; ++bj) store8(h + (size_t)(row0 + ai * 128 + m * 16) * 1024 + col0 + bj * 128, acc[ai][bj][m][0], acc[ai][bj][m][1]);
    }
};
struct EpiResid {
    float* xl; float* xc; const float* gate_base; float coef;
    DI void operator()(AccRef acc, const Unit& u, int wr, int wc, int fr, int fq) const {
        const int row0 = u.pm * 256 + wr * 64 + fr, col0 = u.pn * 256 + wc * 32 + 4 * fq;
        const int mi = (u.pm * 256 < ML) ? ((u.pm * 256) >> 13) : 4;
        const float* gate = gate_base + (size_t)mi * 9216;
        f32x4 gv[2][2];
#pragma unroll
        for (int bj = 0; bj < 2; ++bj)
#pragma unroll
            for (int n = 0; n < 2; ++n) gv[bj][n] = *(const f32x4*)(gate + col0 + bj * 128 + n * 16) * coef;
#pragma unroll
        for (int ai = 0; ai < 2; ++ai)
#pragma unroll
            for (int m = 0; m < 4; ++m) {
                const int rr_ = row0 + ai * 128 + m * 16; float* xp = (rr_ < ML ? xl + (size_t)rr_ * DM : xc + (size_t)(rr_ - ML) * DM) + col0;
#pragma unroll
                for (int bj = 0; bj < 2; ++bj)
#pragma unroll
                    for (int n = 0; n < 2; ++n) { f32x4 x = *(f32x4*)(xp + bj * 128 + n * 16); x = x * ALPHA + gv[bj][n] * acc[ai][bj][m][n]; *(f32x4*)(xp + bj * 128 + n * 16) = x; }
            }
    }
};
struct EpiSplit {
    char* ws;
    DI void operator()(AccRef acc, const Unit& u, int wr, int wc, int fr, int fq) const {
        bf16_t* base; int ld, c0; const int pn = u.pn;
        if (pn < 2) { base = (bf16_t*)(ws + OFF_QB); ld = 512; c0 = pn * 256; }
        else if (pn == 2) { base = (bf16_t*)(ws + OFF_KVB); ld = 256; c0 = 0; }
        else if (pn < 9) { base = (bf16_t*)(ws + OFF_ZR); ld = 1536; c0 = (pn - 3) * 256; }
        else if (pn < 11) { base = (bf16_t*)(ws + OFF_ZS); ld = 512; c0 = (pn - 9) * 256; }
        else { base = (bf16_t*)(ws + OFF_LIN); ld = 512; c0 = (pn - 11) * 256; }
        const int row0 = u.pm * 256 + wr * 64 + fr, col0 = c0 + wc * 32 + 8 * fq;
#pragma unroll
        for (int ai = 0; ai < 2; ++ai)
#pragma unroll
            for (int m = 0; m < 4; ++m)
#pragma unroll
                for (int bj = 0; bj < 2; ++bj) store8(base + (size_t)(row0 + ai * 128 + m * 16) * ld + col0 + bj * 128, acc[ai][bj][m][0], acc[ai][bj][m][1]);
    }
};
struct EpiLora {
    char* ws; const float* w0; const float* a0;
    DI void operator()(AccRef acc, const Unit& u, int wr, int wc, int fr, int fq) const {
        const int kind = u.pn >> 1;
        bf16_t* base = (bf16_t*)(ws + (kind == 0 ? OFF_DWF : kind == 1 ? OFF_DWB : kind == 2 ? OFF_DWA : OFF_G));
        const float* bias = kind < 2 ? w0 + kind * 512 : a0;
        const int row0 = u.pm * 256 + wr * 64 + fr, col0 = (u.pn & 1) * 256 + wc * 32 + 8 * fq;
#pragma unroll
        for (int bj = 0; bj < 2; ++bj) {
            f32x4 b0 = (f32x4){0.f, 0.f, 0.f, 0.f}, b1 = b0;
            if (kind < 3) { b0 = *(const f32x4*)(bias + col0 + bj * 128); b1 = *(const f32x4*)(bias + col0 + bj * 128 + 4); }
#pragma unroll
            for (int ai = 0; ai < 2; ++ai)
#pragma unroll
                for (int m = 0; m < 4; ++m) {
                    f32x4 v0 = acc[ai][bj][m][0] + b0, v1 = acc[ai][bj][m][1] + b1;
                    if (kind < 2) {
#pragma unroll
                        for (int j = 0; j < 4; ++j) { v0[j] = __expf(-0.606531f * sigm(v0[j])); v1[j] = __expf(-0.606531f * sigm(v1[j])); }
                    } else if (kind == 2) {
#pragma unroll
                        for (int j = 0; j < 4; ++j) { v0[j] = sigm(v0[j]); v1[j] = sigm(v1[j]); }
                    }
                    store8(base + (size_t)(row0 + ai * 128 + m * 16) * 512 + col0 + bj * 128, v0, v1);
                }
        }
    }
};
struct EpiGlu {
    const bf16_t* yg; bf16_t* ys; const float* bias;
    DI void operator()(AccRef acc, const Unit& u, int wr, int wc, int fr, int fq) const {
        const int row0 = u.pm * 256 + wr * 64 + fr, col0 = u.pn * 256 + wc * 32 + 8 * fq;
#pragma unroll
        for (int bj = 0; bj < 2; ++bj) {
            const f32x4 b0 = *(const f32x4*)(bias + col0 + bj * 128), b1 = *(const f32x4*)(bias + col0 + bj * 128 + 4);
#pragma unroll
            for (int ai = 0; ai < 2; ++ai)
#pragma unroll
                for (int m = 0; m < 4; ++m) {
                    const size_t o = (size_t)(row0 + ai * 128 + m * 16) * 512 + col0 + bj * 128;
                    const u32x4 y = *(const u32x4*)(yg + o);
                    f32x4 v0 = acc[ai][bj][m][0] + b0, v1 = acc[ai][bj][m][1] + b1;
                    v0[0] = bflo(y.x) * sigm(v0[0]); v0[1] = bfhi(y.x) * sigm(v0[1]); v0[2] = bflo(y.y) * sigm(v0[2]); v0[3] = bfhi(y.y) * sigm(v0[3]);
                    v1[0] = bflo(y.z) * sigm(v1[0]); v1[1] = bfhi(y.z) * sigm(v1[1]); v1[2] = bflo(y.w) * sigm(v1[2]); v1[3] = bfhi(y.w) * sigm(v1[3]);
                    store8(ys + o, v0, v1);
                }
        }
    }
};
struct EpiGate {
    bf16_t* gb;
    DI void operator()(AccRef acc, const Unit& u, int wr, int wc, int fr, int fq) const {
        const int row0 = u.pm * 256 + wr * 64 + fr, col0 = u.pn * 256 + wc * 32 + 8 * fq;
#pragma unroll
        for (int ai = 0; ai < 2; ++ai)
#pragma unroll
            for (int m = 0; m < 4; ++m)
#pragma unroll
                for (int bj = 0; bj < 2; ++bj) { f32x4 a0 = acc[ai][bj][m][0], a1 = acc[ai][bj][m][1];
#pragma unroll
                    for (int j = 0; j < 4; ++j) { a0[j] = sigm(a0[j]); a1[j] = sigm(a1[j]); }
                    store8(gb + (size_t)(row0 + ai * 128 + m * 16) * 1024 + col0 + bj * 128, a0, a1); }
    }
};
struct EpiBranch {
    const bf16_t* gb; bf16_t* mg; int first;
    DI void operator()(AccRef acc, const Unit& u, int wr, int wc, int fr, int fq) const {
        const int row0 = u.pm * 256 + wr * 64 + fr, col0 = u.pn * 256 + wc * 32 + 8 * fq;
#pragma unroll
        for (int ai = 0; ai < 2; ++ai)
#pragma unroll
            for (int m = 0; m < 4; ++m)
#pragma unroll
                for (int bj = 0; bj < 2; ++bj) {
                    const size_t o = (size_t)(row0 + ai * 128 + m * 16) * 1024 + col0 + bj * 128;
                    f32x4 a0 = acc[ai][bj][m][0], a1 = acc[ai][bj][m][1];
                    const u32x4 g = *(const u32x4*)(gb + o);
                    a0[0] *= bflo(g.x); a0[1] *= bfhi(g.x); a0[2] *= bflo(g.y); a0[3] *= bfhi(g.y);
                    a1[0] *= bflo(g.z); a1[1] *= bfhi(g.z); a1[2] *= bflo(g.w); a1[3] *= bfhi(g.w);
                    if (!first) { const u32x4 q = *(const u32x4*)(mg + o);
                        a0[0] += bflo(q.x); a0[1] += bfhi(q.x); a0[2] += bflo(q.y); a0[3] += bfhi(q.y);
                        a1[0] += bflo(q.z); a1[1] += bfhi(q.z); a1[2] += bflo(q.w); a1[3] += bfhi(q.w); }
                    store8(mg + o, a0, a1);
                }
    }
};

__device__ __forceinline__ void phase_ada(const Ctx& cx, float* lds) {
    const int tid = cx.tid;
    for (int i = tid; i < 5 * 1024; i += 512) { const int r = i >> 10, k = i & 1023; const float v = r < 4 ? cx.p->in[I_C][r * 1024 + k] : cx.p->in[I_CCTX][k]; lds[i] = v * sigm(v); }
    __syncthreads();
    float* red = lds + 5120; float* mods = (float*)(cx.p->ws + OFF_MODS);
    for (int task = cx.bid; task < 288; task += cx.nb) {
        const int l = task / 144, n0 = (task % 144) * 64, kc = tid >> 6, col = tid & 63;
        const float* w = cx.p->in[I_WADA] + (size_t)l * 1024 * 9216 + n0 + col;
        float a0 = 0.f, a1 = 0.f, a2 = 0.f, a3 = 0.f, a4 = 0.f;
        for (int k = kc * 128; k < kc * 128 + 128; ++k) { const float wv = w[(size_t)k * 9216]; a0 += lds[k] * wv; a1 += lds[1024 + k] * wv; a2 += lds[2048 + k] * wv; a3 += lds[3072 + k] * wv; a4 += lds[4096 + k] * wv; }
        red[(kc * 5 + 0) * 64 + col] = a0; red[(kc * 5 + 1) * 64 + col] = a1; red[(kc * 5 + 2) * 64 + col] = a2; red[(kc * 5 + 3) * 64 + col] = a3; red[(kc * 5 + 4) * 64 + col] = a4;
        __syncthreads();
        if (tid < 320) { const int r = tid >> 6, c2 = tid & 63; float s = cx.p->in[I_BADA][l * 9216 + n0 + c2];
            for (int q = 0; q < 8; ++q) s += red[(q * 5 + r) * 64 + c2];
            mods[(size_t)(l * 5 + r) * 9216 + n0 + c2] = s; }
        __syncthreads();
    }
}

DI int map_w1(int n) { const int bj = n / 2816, q = n - bj * 2816; return (q >> 7) * 256 + bj * 128 + (q & 127); }
DI int map_win(int n) { return n < 2304 ? n : (n < 2624 ? 2816 + (n - 2304) : (n < 3136 ? 2304 + (n - 2624) : 3328 + (n - 3136))); }
__device__ __forceinline__ void phase_cv(const Ctx& cx, int layer, float* lds) {
    const int tid = cx.tid;
    char* wb = cx.p->ws + OFF_WB;
    const int T0 = 1408, T1 = T0 + 704, T2 = T1 + 1408, T3 = T2 + 704, T4 = T3 + 1552, T5 = T4 + 384, T6 = T5 + 256, T7 = T6 + 64;
    struct CvJob { const float* src; char* dst; int K, N, mode, k0, n0; };
    auto decode = [&](int task) -> CvJob {
        CvJob j; int t;
        if (task < T0) { t = task; j.src = cx.p->in[I_FWIN] + (size_t)(layer * 2 + 0) * 1024 * 5632; j.K = 1024; j.N = 5632; j.mode = 1; j.dst = wb + WB_W1A; }
        else if (task < T1) { t = task - T0; j.src = cx.p->in[I_FWOUT] + (size_t)(layer * 2 + 0) * 2816 * 1024; j.K = 2816; j.N = 1024; j.mode = 0; j.dst = wb + WB_W2A; }
        else if (task < T2) { t = task - T1; j.src = cx.p->in[I_FWIN] + (size_t)(layer * 2 + 1) * 1024 * 5632; j.K = 1024; j.N = 5632; j.mode = 1; j.dst = wb + WB_W1B; }
        else if (task < T3) { t = task - T2; j.src = cx.p->in[I_FWOUT] + (size_t)(layer * 2 + 1) * 2816 * 1024; j.K = 2816; j.N = 1024; j.mode = 0; j.dst = wb + WB_W2B; }
        else if (task < T4) { t = task - T3; j.src = cx.p->in[I_WIN] + (size_t)layer * 1024 * 6208; j.K = 1024; j.N = 6208; j.mode = 2; j.dst = wb + WB_WIN; }
        else if (task < T5) { t = task - T4; const int i = t / 128; t -= i * 128; j.src = cx.p->in[I_BP] + (size_t)(layer * 3 + i) * 512 * 1024; j.K = 512; j.N = 1024; j.mode = 0; j.dst = wb + WB_BP + (size_t)i * 1024 * 512 * 2; }
        else if (task < T6) { t = task - T5; j.src = cx.p->in[I_WOUT] + (size_t)layer * 1024 * 1024; j.K = 1024; j.N = 1024; j.mode = 0; j.dst = wb + WB_WOUT; }
        else { t = task - T6; j.src = cx.p->in[I_GLUW] + (size_t)layer * 512 * 512; j.K = 512; j.N = 512; j.mode = 0; j.dst = wb + WB_GLU; }
        const int nk = j.K / 64; j.k0 = (t % nk) * 64; j.n0 = (t / nk) * 64; return j;
    };
    const int lr_ = tid >> 4, lc4 = (tid & 15) * 4;
    int task = cx.bid; CvJob cur{}; f32x4 va = (f32x4){0.f, 0.f, 0.f, 0.f}, vb = va;
    if (task < T7) { cur = decode(task); va = *(const f32x4*)(cur.src + (size_t)(cur.k0 + lr_) * cur.N + cur.n0 + lc4); vb = *(const f32x4*)(cur.src + (size_t)(cur.k0 + lr_ + 32) * cur.N + cur.n0 + lc4); }
    for (; task < T7; task += cx.nb) {
        const bool hn = task + cx.nb < T7; CvJob nxt = cur; f32x4 na = va, nb2 = vb;
        if (hn) { nxt = decode(task + cx.nb); na = *(const f32x4*)(nxt.src + (size_t)(nxt.k0 + lr_) * nxt.N + nxt.n0 + lc4); nb2 = *(const f32x4*)(nxt.src + (size_t)(nxt.k0 + lr_ + 32) * nxt.N + nxt.n0 + lc4); }
        lds[lr_ * 65 + lc4] = va[0]; lds[lr_ * 65 + lc4 + 1] = va[1]; lds[lr_ * 65 + lc4 + 2] = va[2]; lds[lr_ * 65 + lc4 + 3] = va[3];
        lds[(lr_ + 32) * 65 + lc4] = vb[0]; lds[(lr_ + 32) * 65 + lc4 + 1] = vb[1]; lds[(lr_ + 32) * 65 + lc4 + 2] = vb[2]; lds[(lr_ + 32) * 65 + lc4 + 3] = vb[3];
        __syncthreads();
        {   const int n = tid >> 3, k8 = (tid & 7) * 8; float v[8];
#pragma unroll
            for (int j = 0; j < 8; ++j) v[j] = lds[(k8 + j) * 65 + n];
            const int ng = cur.n0 + n; const int dr = cur.mode == 1 ? map_w1(ng) : (cur.mode == 2 ? map_win(ng) : ng);
            u32x4 w; w.x = pk2(v[0], v[1]); w.y = pk2(v[2], v[3]); w.z = pk2(v[4], v[5]); w.w = pk2(v[6], v[7]);
            *(u32x4*)(cur.dst + ((size_t)dr * cur.K + cur.k0 + k8) * 2) = w; }
        __syncthreads();
        cur = nxt; va = na; vb = nb2;
    }
    const size_t gtid = (size_t)cx.bid * 512 + tid, gsz = (size_t)cx.nb * 512;
    {   u32x4 z = (u32x4){0u, 0u, 0u, 0u}; u32x4* d = (u32x4*)(wb + WB_WIN + (size_t)3136 * 1024 * 2);
        for (size_t i = gtid; i < (size_t)192 * 1024 * 2 / 16; i += gsz) d[i] = z; }
    {   bf16_t* d = (bf16_t*)(wb + WB_LORA);
        const float* w2 = cx.p->in[I_W2] + (size_t)layer * 2 * 64 * 512; const float* a2 = cx.p->in[I_A2] + (size_t)layer * 64 * 512; const float* g2 = cx.p->in[I_G2] + (size_t)layer * 128 * 512;
        for (size_t i = gtid; i < (size_t)2048 * 384; i += gsz) { const int n = (int)(i / 384), k = (int)(i % 384); const int kind = n >> 9, c = n & 511; float v = 0.f;
            if (kind == 0) { if (k < 64) v = w2[(size_t)k * 512 + c]; }
            else if (kind == 1) { if (k >= 64 && k < 128) v = w2[(size_t)(64 + k - 64) * 512 + c]; }
            else if (kind == 2) { if (k >= 128 && k < 192) v = a2[(size_t)(k - 128) * 512 + c]; }
            else { if (k >= 192 && k < 320) v = g2[(size_t)(k - 192) * 512 + c]; }
            d[i] = f2bf(v); } }
}

DI void row_stats2(f32x4 (&v)[2][4], float (&rstd)[2]) {
    float s[2], q[2];
#pragma unroll
    for (int k = 0; k < 2; ++k) { s[k] = 0.f;
#pragma unroll
        for (int i = 0; i < 4; ++i) s[k] += v[k][i][0] + v[k][i][1] + v[k][i][2] + v[k][i][3]; }
    s[0] += swz<1>(s[0]); s[1] += swz<1>(s[1]); s[0] += swz<2>(s[0]); s[1] += swz<2>(s[1]); s[0] += swz<4>(s[0]); s[1] += swz<4>(s[1]);
    s[0] += swz<8>(s[0]); s[1] += swz<8>(s[1]); s[0] += swz<16>(s[0]); s[1] += swz<16>(s[1]);
#pragma unroll
    for (int k = 0; k < 2; ++k) {
        const float mean = (__builtin_bit_cast(float, __builtin_amdgcn_readlane(__builtin_bit_cast(int, s[k]), 0)) + __builtin_bit_cast(float, __builtin_amdgcn_readlane(__builtin_bit_cast(int, s[k]), 32))) * (1.0f / 1024.0f);
        q[k] = 0.f;
#pragma unroll
        for (int i = 0; i < 4; ++i) { v[k][i] -= mean; q[k] += v[k][i][0] * v[k][i][0] + v[k][i][1] * v[k][i][1] + v[k][i][2] * v[k][i][2] + v[k][i][3] * v[k][i][3]; }
    }
    q[0] += swz<1>(q[0]); q[1] += swz<1>(q[1]); q[0] += swz<2>(q[0]); q[1] += swz<2>(q[1]); q[0] += swz<4>(q[0]); q[1] += swz<4>(q[1]);
    q[0] += swz<8>(q[0]); q[1] += swz<8>(q[1]); q[0] += swz<16>(q[0]); q[1] += swz<16>(q[1]);
#pragma unroll
    for (int k = 0; k < 2; ++k) {
        const float var = (__builtin_bit_cast(float, __builtin_amdgcn_readlane(__builtin_bit_cast(int, q[k]), 0)) + __builtin_bit_cast(float, __builtin_amdgcn_readlane(__builtin_bit_cast(int, q[k]), 32))) * (1.0f / 1024.0f);
        rstd[k] = rsqrtf(var + 1e-6f);
    }
}
template <int MODE>
__device__ __forceinline__ void phase_row(const Ctx& cx, int M, const float* lng, const float* lnb, const float* mod_base  , bf16_t* U,
                                          const float* gate_base = nullptr, float coef = 0.f, const bf16_t* H = nullptr) {
    const int lane = cx.tid & 63, gw = cx.bid * 8 + (cx.tid >> 6), nw = cx.nb * 8;
    f32x4 nv[2][4]; u32x2 nh[2][4];
    auto issue = [&](int pi) {
#pragma unroll
        for (int k = 0; k < 2; ++k) {
            const int r = 2 * pi + k;
            const float* src = (MODE & 1) ? (r < ML ? cx.p->in[I_X] + (size_t)r * DM : cx.p->in[I_CTX] + (size_t)(r - ML) * DM) : xrow(cx, r);
#pragma unroll
            for (int i = 0; i < 4; ++i) { nv[k][i] = *(const f32x4*)(src + i * 256 + lane * 4); if (MODE & 8) nh[k][i] = *(const u32x2*)(H + (size_t)r * DM + i * 256 + lane * 4); }
        }
    };
    const int npair = M >> 1;
    const int p_beg = (int)(((long)gw * npair) / nw), p_end = (int)(((long)(gw + 1) * npair) / nw);
    f32x4 gv[4], lg[4], lb[4], sc4[4], sh4[4]; int cur_mi = -1;
#pragma unroll
    for (int i = 0; i < 4; ++i) { gv[i] = (f32x4){0.f, 0.f, 0.f, 0.f}; sc4[i] = gv[i]; sh4[i] = gv[i]; lg[i] = gv[i]; lb[i] = gv[i];
        if (MODE & 2) { lg[i] = *(const f32x4*)(lng + i * 256 + lane * 4); lb[i] = *(const f32x4*)(lnb + i * 256 + lane * 4); } }
    if (p_beg < p_end) issue(p_beg);
    for (int pi = p_beg; pi < p_end; ++pi) {
        const int r0 = 2 * pi; const int mi = r0 < ML ? (r0 >> 13) : 4;
        if (mi != cur_mi) { cur_mi = mi;
#pragma unroll
            for (int i = 0; i < 4; ++i) {
                if (MODE & 8) gv[i] = *(const f32x4*)(gate_base + (size_t)mi * 9216 + i * 256 + lane * 4);
                if (MODE & 4) { sh4[i] = *(const f32x4*)(mod_base + (size_t)mi * 9216 + i * 256 + lane * 4); sc4[i] = *(const f32x4*)(mod_base + (size_t)mi * 9216 + 1024 + i * 256 + lane * 4); }
            }
        }
        f32x4 v[2][4]; float* xp[2];
#pragma unroll
        for (int k = 0; k < 2; ++k) { xp[k] = xrow(cx, r0 + k);
#pragma unroll
            for (int i = 0; i < 4; ++i) {
                if (MODE & 8) { const u32x2 hw = nh[k][i]; v[k][i] = nv[k][i] * ALPHA + (gv[i] * coef) * (f32x4){bflo(hw.x), bfhi(hw.x), bflo(hw.y), bfhi(hw.y)}; }
                else v[k][i] = nv[k][i];
            } }
        __builtin_amdgcn_sched_barrier(0);
        issue((pi + 1 < p_end) ? pi + 1 : pi);
        __builtin_amdgcn_sched_barrier(0);
        if ((MODE & 1) && !(MODE & 16) && !(MODE & 2)) {
#pragma unroll
            for (int k = 0; k < 2; ++k)
#pragma unroll
                for (int i = 0; i < 4; ++i) *(f32x4*)(xp[k] + i * 256 + lane * 4) = v[k][i];
        }
        if (MODE & 2) {
            float rstd[2]; row_stats2(v, rstd);
#pragma unroll
            for (int i = 0; i < 4; ++i)
#pragma unroll
                for (int k = 0; k < 2; ++k) { v[k][i] = v[k][i] * rstd[k] * lg[i] + lb[i]; *(f32x4*)(xp[k] + i * 256 + lane * 4) = v[k][i]; }
        }
        if (MODE & 4) {
            float rstd[2]; row_stats2(v, rstd);
#pragma unroll
            for (int k = 0; k < 2; ++k)
#pragma unroll
                for (int i = 0; i < 4; ++i) { const f32x4 y = v[k][i] * rstd[k] * (sc4[i] + 1.0f) + sh4[i]; u32x2 w; w.x = pk2(y[0], y[1]); w.y = pk2(y[2], y[3]); *(u32x2*)(U + (size_t)(r0 + k) * DM + i * 256 + lane * 4) = w; }
        }
    }
}

__device__ __forceinline__ void phase_ap(const Ctx& cx, int layer) {
    const int lane = cx.tid & 63, gw = cx.bid * 8 + (cx.tid >> 6), nw = cx.nb * 8;
    bf16_t* Q = (bf16_t*)(cx.p->ws + OFF_QB); const bf16_t* KV = (const bf16_t*)(cx.p->ws + OFF_KVB);
    bf16_t* Kr = (bf16_t*)(cx.p->ws + OFF_KR); bf16_t* Vt = (bf16_t*)(cx.p->ws + OFF_VT);
    const bf16_t* ZR = (const bf16_t*)(cx.p->ws + OFF_ZR); const bf16_t* LIN = (const bf16_t*)(cx.p->ws + OFF_LIN);
    bf16_t* ZF = (bf16_t*)(cx.p->ws + OFF_ZF); bf16_t* AP = (bf16_t*)(cx.p->ws + OFF_AP);
    const float* mu = cx.p->in[I_MU] + (size_t)layer * 1856;
    const float QS = 0.125f * LOG2E;
    for (int r = gw; r < MT; r += nw) {
        const bool lat = r < ML; int b, pos, prow = 0, pcol = 0, first, lastt;
        if (lat) { b = r >> 13; const int t = r & 8191; pos = 256 + t; prow = t >> 6; pcol = t & 63; first = (t == 0); lastt = (t == 8191); }
        else { const int q = r - ML; b = q >> 8; pos = q & 255; first = (pos == 0); lastt = (pos == 255); }
#pragma unroll
        for (int i = 0; i < 4; ++i) {
            const int pg = lane + 64 * i, hd = pg >> 5, pi = pg & 31, half = pi >> 4, i16 = pi & 15; const int i1 = hd * 64 + half * 32 + i16;
            const float x1 = bf2f(Q[(size_t)r * 512 + i1]), x2 = bf2f(Q[(size_t)r * 512 + i1 + 16]);
            float c = 1.f, s = 0.f;
            if (lat) { const float ang = (float)(half ? pcol : prow) * exp2f(-(float)i16 * (13.287712379549449f / 16.0f)); c = __cosf(ang); s = __sinf(ang); }
            Q[(size_t)r * 512 + i1] = f2bf((x1 * c - x2 * s) * QS); Q[(size_t)r * 512 + i1 + 16] = f2bf((x2 * c + x1 * s) * QS);
        }
        {
            const int hd = lane >> 5, pi = lane & 31, half = pi >> 4, i16 = pi & 15; const int i1 = hd * 64 + half * 32 + i16;
            const float x1 = bf2f(KV[(size_t)r * 256 + i1]), x2 = bf2f(KV[(size_t)r * 256 + i1 + 16]);
            float c = 1.f, s = 0.f;
            if (lat) { const float ang = (float)(half ? pcol : prow) * exp2f(-(float)i16 * (13.287712379549449f / 16.0f)); c = __cosf(ang); s = __sinf(ang); }
            bf16_t* kd = Kr + ((size_t)(b * 2 + hd) * 8448 + pos) * 64 + half * 32 + i16;
            kd[0] = f2bf(x1 * c - x2 * s); kd[16] = f2bf(x2 * c + x1 * s);
        }
#pragma unroll
        for (int i = 0; i < 2; ++i) { const int idx = lane + 64 * i, hk = idx >> 6, d = idx & 63; Vt[((size_t)(b * 2 + hk) * 64 + d) * 8448 + pos] = KV[(size_t)r * 256 + 128 + idx]; }
#pragma unroll
        for (int i = 0; i < 3; ++i) {
            const int c0 = i * 512 + lane * 8; const u32x4 zc = *(const u32x4*)(ZR + (size_t)r * 1536 + c0);
            u32x4 zp = (u32x4){0u, 0u, 0u, 0u}, zn = zp;
            if (!first) zp = *(const u32x4*)(ZR + (size_t)(r - 1) * 1536 + c0);
            if (!lastt) zn = *(const u32x4*)(ZR + (size_t)(r + 1) * 1536 + c0);
            const f32x4 m0 = *(const f32x4*)(mu + c0), m1 = *(const f32x4*)(mu + c0 + 4);
            float o[8]; const unsigned cw[4] = {zc.x, zc.y, zc.z, zc.w}, pw[4] = {zp.x, zp.y, zp.z, zp.w}, nwv[4] = {zn.x, zn.y, zn.z, zn.w};
#pragma unroll
            for (int j = 0; j < 4; ++j) { const float ma = j < 2 ? m0[2 * j] : m1[2 * j - 4], mb = j < 2 ? m0[2 * j + 1] : m1[2 * j - 3];
                const float za = bflo(cw[j]), zb = bfhi(cw[j]);
                o[2 * j] = za + ma * (0.5f * (bflo(pw[j]) + bflo(nwv[j])) - za); o[2 * j + 1] = zb + mb * (0.5f * (bfhi(pw[j]) + bfhi(nwv[j])) - zb); }
            u32x4 w; w.x = pk2(o[0], o[1]); w.y = pk2(o[2], o[3]); w.z = pk2(o[4], o[5]); w.w = pk2(o[6], o[7]);
            *(u32x4*)(ZF + (size_t)r * 1536 + c0) = w;
        }
        if (lane < 48) {
            const int c0 = lane * 8; u32x4 w = (u32x4){0u, 0u, 0u, 0u};
            if (lane < 40) {
                const u32x4 zc = *(const u32x4*)(LIN + (size_t)r * 512 + c0); u32x4 zp = (u32x4){0u, 0u, 0u, 0u}, zn = zp;
                if (!first) zp = *(const u32x4*)(LIN + (size_t)(r - 1) * 512 + c0);
                if (!lastt) zn = *(const u32x4*)(LIN + (size_t)(r + 1) * 512 + c0);
                const f32x4 m0 = *(const f32x4*)(mu + 1536 + c0), m1 = *(const f32x4*)(mu + 1536 + c0 + 4);
                float o[8]; const unsigned cw[4] = {zc.x, zc.y, zc.z, zc.w}, pw[4] = {zp.x, zp.y, zp.z, zp.w}, nwv[4] = {zn.x, zn.y, zn.z, zn.w};
#pragma unroll
                for (int j = 0; j < 4; ++j) { const float ma = j < 2 ? m0[2 * j] : m1[2 * j - 4], mb = j < 2 ? m0[2 * j + 1] : m1[2 * j - 3];
                    const float za = bflo(cw[j]), zb = bfhi(cw[j]);
                    o[2 * j] = za + ma * (0.5f * (bflo(pw[j]) + bflo(nwv[j])) - za); o[2 * j + 1] = zb + mb * (0.5f * (bfhi(pw[j]) + bfhi(nwv[j])) - zb); }
                if (c0 < 128) {
#pragma unroll
                    for (int j = 0; j < 8; ++j) o[j] = 1.0f - 2.0f * __builtin_amdgcn_rcpf(1.0f + __expf(2.0f * o[j]));
                } else if (c0 >= 192) {
#pragma unroll
                    for (int j = 0; j < 8; ++j) o[j] = sigm(o[j]);
                }
                w.x = pk2(o[0], o[1]); w.y = pk2(o[2], o[3]); w.z = pk2(o[4], o[5]); w.w = pk2(o[6], o[7]);
            }
            *(u32x4*)(AP + (size_t)r * 384 + c0) = w;
        }
    }
}

__device__ __forceinline__ void phase_attn(const Ctx& cx, int layer, bf16_t* Out) {
    const int lane = cx.tid & 63, gw = cx.bid * 8 + (cx.tid >> 6), nw = cx.nb * 8, fr = lane & 15, fq = lane >> 4;
    const bf16_t* Q = (const bf16_t*)(cx.p->ws + OFF_QB); const bf16_t* Kr = (const bf16_t*)(cx.p->ws + OFF_KR); const bf16_t* Vt = (const bf16_t*)(cx.p->ws + OFF_VT);
    const int ntask = layer == 1 ? 4096 : 4224;
    for (int task = gw; task < ntask; task += nw) {
        const bool isctx = task >= 4096; const int tt = isctx ? task - 4096 : task; const int hk = tt & 1, qt = tt >> 1;
        int b, q0, rowbase;
        if (!isctx) { b = qt >> 9; q0 = (qt & 511) * 16; rowbase = b * 8192 + q0; } else { b = qt >> 4; q0 = (qt & 15) * 16; rowbase = ML + b * 256 + q0; }
        const bf16_t* Kb = Kr + (size_t)(b * 2 + hk) * 8448 * 64; const bf16_t* Vb = Vt + (size_t)(b * 2 + hk) * 64 * 8448;
        bf16x8 qf[4][2]; float mrun[4], lsum[4]; f32x4 o[4][4];
#pragma unroll
        for (int g = 0; g < 4; ++g) {
#pragma unroll
            for (int ks = 0; ks < 2; ++ks) qf[g][ks] = *(const bf16x8*)(Q + (size_t)(rowbase + fr) * 512 + (hk * 4 + g) * 64 + ks * 32 + fq * 8);
            mrun[g] = cx.p->in[I_SINK][layer * 8 + hk * 4 + g] * LOG2E; lsum[g] = (fq == 0) ? 1.0f : 0.0f;
#pragma unroll
            for (int mt = 0; mt < 4; ++mt) o[g][mt] = (f32x4){0.f, 0.f, 0.f, 0.f};
        }
        int kt_lo = 0, n2 = 0;
        if (!isctx) { kt_lo = q0 - 128; if (kt_lo < 0) kt_lo = 0; kt_lo &= ~31; int kt_hi = q0 + 16 + 128; if (kt_hi > 8192) kt_hi = 8192; kt_hi = (kt_hi + 31) & ~31; n2 = (kt_hi - kt_lo) >> 5; }
        const int tq = q0 + fr, ntile = 8 + n2;
        bf16x8 kf[2][2]; u32x2 vf[4][2];
        {   const int pos0 = 0;
#pragma unroll
            for (int ks = 0; ks < 2; ++ks) { kf[0][ks] = *(const bf16x8*)(Kb + (size_t)(pos0 + fr) * 64 + ks * 32 + fq * 8); kf[1][ks] = *(const bf16x8*)(Kb + (size_t)(pos0 + 16 + fr) * 64 + ks * 32 + fq * 8); }
#pragma unroll
            for (int mt = 0; mt < 4; ++mt) { const bf16_t* vp = Vb + (size_t)(mt * 16 + fr) * 8448 + pos0 + fq * 4; vf[mt][0] = *(const u32x2*)vp; vf[mt][1] = *(const u32x2*)(vp + 16); } }
        for (int it = 0; it < ntile; ++it) {
            const bool loc = it >= 8; const int kt = loc ? kt_lo + (it - 8) * 32 : 0;
            bf16x8 kn[2][2]; u32x2 vn[4][2];
            {   const int itn = (it + 1 < ntile) ? it + 1 : it; const int pos0 = itn >= 8 ? 256 + kt_lo + (itn - 8) * 32 : itn * 32;
#pragma unroll
                for (int ks = 0; ks < 2; ++ks) { kn[0][ks] = *(const bf16x8*)(Kb + (size_t)(pos0 + fr) * 64 + ks * 32 + fq * 8); kn[1][ks] = *(const bf16x8*)(Kb + (size_t)(pos0 + 16 + fr) * 64 + ks * 32 + fq * 8); }
#pragma unroll
                for (int mt = 0; mt < 4; ++mt) { const bf16_t* vp = Vb + (size_t)(mt * 16 + fr) * 8448 + pos0 + fq * 4; vn[mt][0] = *(const u32x2*)vp; vn[mt][1] = *(const u32x2*)(vp + 16); } }
            bool msk0[4], msk1[4];
#pragma unroll
            for (int j = 0; j < 4; ++j) { const int d0 = kt + fq * 4 + j - tq, d1 = d0 + 16; msk0[j] = loc && (d0 > 128 || d0 < -128); msk1[j] = loc && (d1 > 128 || d1 < -128); }
            f32x4 s0[4], s1[4]; float mx[4], al[4];
#pragma unroll
            for (int g = 0; g < 4; ++g) {
                s0[g] = (f32x4){0.f, 0.f, 0.f, 0.f}; s1[g] = s0[g];
#pragma unroll
                for (int ks = 0; ks < 2; ++ks) { s0[g] = __builtin_amdgcn_mfma_f32_16x16x32_bf16(kf[0][ks], qf[g][ks], s0[g], 0, 0, 0); s1[g] = __builtin_amdgcn_mfma_f32_16x16x32_bf16(kf[1][ks], qf[g][ks], s1[g], 0, 0, 0); }
            }
#pragma unroll
            for (int g = 0; g < 4; ++g) {
#pragma unroll
                for (int j = 0; j < 4; ++j) { if (msk0[j]) s0[g][j] = -1e30f; if (msk1[j]) s1[g][j] = -1e30f; }
                mx[g] = fmaxf(fmaxf(fmaxf(s0[g][0], s0[g][1]), fmaxf(s0[g][2], s0[g][3])), fmaxf(fmaxf(s1[g][0], s1[g][1]), fmaxf(s1[g][2], s1[g][3])));
            }
#pragma unroll
            for (int g = 0; g < 4; ++g) mx[g] = fmaxf(mx[g], swz<16>(mx[g]));
#pragma unroll
            for (int g = 0; g < 4; ++g) mx[g] = fmaxf(mx[g], xor32(lane, mx[g]));
            bf16x8 pf[4];
#pragma unroll
            for (int g = 0; g < 4; ++g) {
                const float mn = fmaxf(mrun[g], mx[g]); al[g] = __builtin_amdgcn_exp2f(mrun[g] - mn); mrun[g] = mn;
                float ps = 0.f;
#pragma unroll
                for (int j = 0; j < 4; ++j) { s0[g][j] = __builtin_amdgcn_exp2f(s0[g][j] - mn); s1[g][j] = __builtin_amdgcn_exp2f(s1[g][j] - mn); ps += s0[g][j] + s1[g][j]; }
                lsum[g] = lsum[g] * al[g] + ps;
                u32x4 pw; pw.x = pk2(s0[g][0], s0[g][1]); pw.y = pk2(s0[g][2], s0[g][3]); pw.z = pk2(s1[g][0], s1[g][1]); pw.w = pk2(s1[g][2], s1[g][3]);
                pf[g] = __builtin_bit_cast(bf16x8, pw);
            }
#pragma unroll
            for (int mt = 0; mt < 4; ++mt) {
                u32x4 vw; vw.x = vf[mt][0].x; vw.y = vf[mt][0].y; vw.z = vf[mt][1].x; vw.w = vf[mt][1].y;
                const bf16x8 vfrag = __builtin_bit_cast(bf16x8, vw);
#pragma unroll
                for (int g = 0; g < 4; ++g) { o[g][mt] = o[g][mt] * al[g]; o[g][mt] = __builtin_amdgcn_mfma_f32_16x16x32_bf16(vfrag, pf[g], o[g][mt], 0, 0, 0); }
            }
#pragma unroll
            for (int ks = 0; ks < 2; ++ks) { kf[0][ks] = kn[0][ks]; kf[1][ks] = kn[1][ks]; }
#pragma unroll
            for (int mt = 0; mt < 4; ++mt) { vf[mt][0] = vn[mt][0]; vf[mt][1] = vn[mt][1]; }
        }
#pragma unroll
        for (int g = 0; g < 4; ++g) {
            float ls = lsum[g]; ls += swz<16>(ls); ls += xor32(lane, ls);
            const float inv = 1.0f / ls;
#pragma unroll
            for (int mt = 0; mt < 4; ++mt) { u32x2 w; w.x = pk2(o[g][mt][0] * inv, o[g][mt][1] * inv); w.y = pk2(o[g][mt][2] * inv, o[g][mt][3] * inv);
                *(u32x2*)(Out + (size_t)(rowbase + fr) * 512 + (hk * 4 + g) * 64 + mt * 16 + fq * 4) = w; }
        }
    }
}

__device__ __forceinline__ void phase_s5(const Ctx& cx, int layer, LAS unsigned char* lds) {
    const int tid = cx.tid, lane = tid & 63, wid = tid >> 6, fr = lane & 15, fq = lane >> 4;
    const bf16_t* ZS = (const bf16_t*)(cx.p->ws + OFF_ZS);
    LAS bf16_t* bbar = (LAS bf16_t*)lds;
    LAS float* Db = (LAS float*)(lds + 4096 + wid * 12800);
    LAS bf16_t* Xb = (LAS bf16_t*)(lds + 4096 + wid * 12800 + 8448);
    LAS float* Ex = (LAS float*)(lds + 4096 + 8 * 12800);
    for (int task = cx.bid; task < 256; task += cx.nb) {
        const int dir = task & 1, g = (task >> 1) & 31, b = task >> 6;
        const int pidx = ((layer * 2 + dir) * 32 + g) * 64 + lane;
        const float are = cx.p->in[I_SARE][pidx], aim = cx.p->in[I_SAIM][pidx], dt = __expf(cx.p->in[I_SLOG][(layer * 2 + dir) * 32 + g]);
        const float mag = __expf(are * dt), lr = mag * __cosf(aim * dt), li = mag * __sinf(aim * dt);
        __syncthreads();
        if (wid == 0) {
            const float den = are * are + aim * aim, cr = ((lr - 1.0f) * are + li * aim) / den, ci = (li * are - (lr - 1.0f) * aim) / den;
            const float* br = cx.p->in[I_SBRE] + ((size_t)(layer * 32 + g) * 64 + lane) * 16; const float* bi = cx.p->in[I_SBIM] + ((size_t)(layer * 32 + g) * 64 + lane) * 16;
#pragma unroll
            for (int c = 0; c < 16; ++c) { const float x = br[c], y = bi[c]; bbar[lane * 16 + c] = f2bf(cr * x - ci * y); bbar[(64 + lane) * 16 + c] = f2bf(cr * y + ci * x); }
        }
        __syncthreads();
        bf16x8 bfr[8];
#pragma unroll
        for (int t = 0; t < 8; ++t) { bfr[t] = (bf16x8){0, 0, 0, 0, 0, 0, 0, 0}; if (fq < 2) bfr[t] = *(const LAS bf16x8*)(bbar + (t * 16 + fr) * 16 + fq * 8); }
        bf16x8 cfr[4];
        {   const float* cre = cx.p->in[I_SCRE] + ((size_t)(layer * 32 + g) * 16 + fr) * 64; const float* cim = cx.p->in[I_SCIM] + ((size_t)(layer * 32 + g) * 16 + fr) * 64;
#pragma unroll
            for (int ks = 0; ks < 4; ++ks) { const int k0 = ks * 32 + fq * 8; u32x4 w;
                if (k0 < 64) { const f32x4 a = *(const f32x4*)(cre + k0), c = *(const f32x4*)(cre + k0 + 4); w.x = pk2(a[0], a[1]); w.y = pk2(a[2], a[3]); w.z = pk2(c[0], c[1]); w.w = pk2(c[2], c[3]); }
                else { const f32x4 a = *(const f32x4*)(cim + k0 - 64), c = *(const f32x4*)(cim + k0 - 60); w.x = pk2(-a[0], -a[1]); w.y = pk2(-a[2], -a[3]); w.z = pk2(-c[0], -c[1]); w.w = pk2(-c[2], -c[3]); }
                cfr[ks] = __builtin_bit_cast(bf16x8, w); } }
        float pr = lr, pi = li;
#pragma unroll
        for (int i = 0; i < 5; ++i) { const float a = pr * pr - pi * pi, c = 2.0f * pr * pi; pr = a; pi = c; }
        const float p32r = pr, p32i = pi;
#pragma unroll
        for (int i = 0; i < 5; ++i) { const float a = pr * pr - pi * pi, c = 2.0f * pr * pi; pr = a; pi = c; }
        { const float a = pr * p32r - pi * p32i, c = pr * p32i + pi * p32r; pr = a; pi = c; }
        bf16_t* Y = (bf16_t*)(cx.p->ws + (dir ? OFF_YB : OFF_YF));
        float hr = 0.f, hi = 0.f;
        for (int pass = 0; pass < 2; ++pass) {
            bf16x8 ufn = (bf16x8){0, 0, 0, 0, 0, 0, 0, 0};
            if (fq < 2) ufn = *(const bf16x8*)(ZS + (size_t)tokrow(b, dir, wid * 1056 + fr) * 512 + g * 16 + fq * 8);
            for (int grp = 0; grp < 66; ++grp) {
                const int p0 = wid * 1056 + grp * 16;
                const bf16x8 uf = ufn;
                if (fq < 2 && grp < 65) ufn = *(const bf16x8*)(ZS + (size_t)tokrow(b, dir, p0 + 16 + fr) * 512 + g * 16 + fq * 8);
#pragma unroll
                for (int t = 0; t < 8; ++t) {
                    const f32x4 d = __builtin_amdgcn_mfma_f32_16x16x32_bf16(uf, bfr[t], (f32x4){0.f, 0.f, 0.f, 0.f}, 0, 0, 0);
#pragma unroll
                    for (int j = 0; j < 4; ++j) Db[(fq * 4 + j) * 132 + t * 16 + fr] = d[j];
                }
                wave_lds_sync();
#pragma unroll
                for (int tk = 0; tk < 16; ++tk) {
                    const float dr = Db[tk * 132 + lane], di = Db[tk * 132 + 64 + lane];
                    const float nr = lr * hr - li * hi + dr, ni = lr * hi + li * hr + di; hr = nr; hi = ni;
                    if (pass) { Xb[tk * 136 + lane] = f2bf(hr); Xb[tk * 136 + 64 + lane] = f2bf(hi); }
                }
                wave_lds_sync();
                if (pass) {
                    f32x4 y = (f32x4){0.f, 0.f, 0.f, 0.f};
#pragma unroll
                    for (int ks = 0; ks < 4; ++ks) { const bf16x8 xf = *(const LAS bf16x8*)(Xb + fr * 136 + ks * 32 + fq * 8); y = __builtin_amdgcn_mfma_f32_16x16x32_bf16(xf, cfr[ks], y, 0, 0, 0); }
#pragma unroll
                    for (int j = 0; j < 4; ++j) Y[(size_t)tokrow(b, dir, p0 + fq * 4 + j) * 512 + g * 16 + fr] = f2bf(y[j]);
                    wave_lds_sync();
                }
            }
            if (pass == 0) {
                Ex[wid * 128 + lane] = hr; Ex[wid * 128 + 64 + lane] = hi;
                __syncthreads();
                hr = 0.f; hi = 0.f;
                for (int v = 0; v < wid; ++v) { const float er = Ex[v * 128 + lane], ei = Ex[v * 128 + 64 + lane]; const float nr = pr * hr - pi * hi + er, ni = pr * hi + pi * hr + ei; hr = nr; hi = ni; }
            }
        }
    }
}
__device__ __forceinline__ void phase_s5gelu(const Ctx& cx, int layer) {
    const size_t gtid = (size_t)cx.bid * 512 + cx.tid, gsz = (size_t)cx.nb * 512;
    bf16_t* ZS = (bf16_t*)(cx.p->ws + OFF_ZS); const bf16_t* YF = (const bf16_t*)(cx.p->ws + OFF_YF); const bf16_t* YB = (const bf16_t*)(cx.p->ws + OFF_YB);
    const float* dd = cx.p->in[I_SD] + layer * 512;
    for (size_t i = gtid; i < (size_t)MT * 64; i += gsz) {
        const int c0 = (int)(i & 63) * 8; const size_t o = i * 8;
        const u32x4 u = *(const u32x4*)(ZS + o), a = *(const u32x4*)(YF + o), b = *(const u32x4*)(YB + o);
        const unsigned uw[4] = {u.x, u.y, u.z, u.w}, aw[4] = {a.x, a.y, a.z, a.w}, bw[4] = {b.x, b.y, b.z, b.w}; float v[8];
#pragma unroll
        for (int j = 0; j < 4; ++j) { v[2 * j] = bflo(aw[j]) + bflo(bw[j]) + dd[c0 + 2 * j] * bflo(uw[j]); v[2 * j + 1] = bfhi(aw[j]) + bfhi(bw[j]) + dd[c0 + 2 * j + 1] * bfhi(uw[j]); }
#pragma unroll
        for (int j = 0; j < 8; ++j) { const float y = v[j], z = 0.7978845608028654f * (y + 0.044715f * y * y * y); const float th = 1.0f - 2.0f * __builtin_amdgcn_rcpf(1.0f + __expf(2.0f * z)); v[j] = 0.5f * y * (1.0f + th); }
        u32x4 w; w.x = pk2(v[0], v[1]); w.y = pk2(v[2], v[3]); w.z = pk2(v[4], v[5]); w.w = pk2(v[6], v[7]);
        *(u32x4*)(ZS + o) = w;
    }
}

DI float quad_allsum(float x) {
    x += __builtin_bit_cast(float, __builtin_amdgcn_mov_dpp(__builtin_bit_cast(int, x), 0xB1, 0xF, 0xF, true));
    x += __builtin_bit_cast(float, __builtin_amdgcn_mov_dpp(__builtin_bit_cast(int, x), 0x4E, 0xF, 0xF, true));
    return x;
}
template <int NR, bool HASV, bool HASO>
DI void rwkv_step(f32x2 (&S)[NR][8], const LAS float* sb, int cg, int voff, float (&o)[NR]) {
    float sa[NR];
    {   f32x2 ac[NR];
#pragma unroll
        for (int ii = 0; ii < NR; ++ii) ac[ii] = (f32x2){0.f, 0.f};
#pragma unroll
        for (int q = 0; q < 4; ++q) { const f32x4 k4 = *(const LAS f32x4*)(sb + 64 + 16 * cg + 4 * q); const f32x2 k0 = (f32x2){k4[0], k4[1]}, k1 = (f32x2){k4[2], k4[3]};
#pragma unroll
            for (int ii = 0; ii < NR; ++ii) { ac[ii] += S[ii][2 * q] * k0; ac[ii] += S[ii][2 * q + 1] * k1; } }
#pragma unroll
        for (int ii = 0; ii < NR; ++ii) sa[ii] = quad_allsum(ac[ii][0] + ac[ii][1]);
    }
    float vv[NR];
#pragma unroll
    for (int ii = 0; ii < NR; ++ii) vv[ii] = 0.f;
    if (HASV) {
        if (NR == 4) { const f32x4 v4 = *(const LAS f32x4*)(sb + 320 + voff); vv[0] = v4[0]; vv[1] = v4[1]; vv[NR - 2] = v4[2]; vv[NR - 1] = v4[3]; }
        else { const f32x2 v2 = *(const LAS f32x2*)(sb + 320 + voff); vv[0] = v2[0]; vv[1] = v2[1]; }
    }
    f32x2 oc[NR];
#pragma unroll
    for (int ii = 0; ii < NR; ++ii) oc[ii] = (f32x2){0.f, 0.f};
#pragma unroll
    for (int q = 0; q < 4; ++q) {
        const f32x4 w4 = *(const LAS f32x4*)(sb + 16 * cg + 4 * q), b4 = *(const LAS f32x4*)(sb + 128 + 16 * cg + 4 * q);
        const f32x2 w0 = (f32x2){w4[0], w4[1]}, w1 = (f32x2){w4[2], w4[3]}, b0 = (f32x2){b4[0], b4[1]}, b1 = (f32x2){b4[2], b4[3]};
        f32x2 k0 = (f32x2){0.f, 0.f}, k1 = k0, r0 = k0, r1 = k0;
        if (HASV) { const f32x4 k4 = *(const LAS f32x4*)(sb + 192 + 16 * cg + 4 * q); k0 = (f32x2){k4[0], k4[1]}; k1 = (f32x2){k4[2], k4[3]}; }
        if (HASO) { const f32x4 r4 = *(const LAS f32x4*)(sb + 256 + 16 * cg + 4 * q); r0 = (f32x2){r4[0], r4[1]}; r1 = (f32x2){r4[2], r4[3]}; }
#pragma unroll
        for (int ii = 0; ii < NR; ++ii) {
            const f32x2 nsa2 = (f32x2){-sa[ii], -sa[ii]};
            if (HASV) { const f32x2 v2 = (f32x2){vv[ii], vv[ii]}; S[ii][2 * q] = S[ii][2 * q] * w0 + (nsa2 * b0 + v2 * k0); S[ii][2 * q + 1] = S[ii][2 * q + 1] * w1 + (nsa2 * b1 + v2 * k1); }
            else { S[ii][2 * q] = S[ii][2 * q] * w0 + nsa2 * b0; S[ii][2 * q + 1] = S[ii][2 * q + 1] * w1 + nsa2 * b1; }
            if (HASO) { oc[ii] += S[ii][2 * q] * r0; oc[ii] += S[ii][2 * q + 1] * r1; }
        }
    }
#pragma unroll
    for (int ii = 0; ii < NR; ++ii) o[ii] = HASO ? quad_allsum(oc[ii][0] + oc[ii][1]) : 0.f;
}
template <bool PB>
__device__ __forceinline__ void phase_rwkv_scan(const Ctx& cx, int layer, LAS unsigned char* lds) {
    constexpr int NR = PB ? 2 : 4;
    const int tid = cx.tid, lane = tid & 63, wid = __builtin_amdgcn_readfirstlane(tid >> 6), pair = wid & 3, sub = wid >> 2;
    const int rg = lane >> 2, cg = lane & 3;
    const int rowbase = PB ? 32 * sub + 2 * rg : 4 * rg;
    LAS float* stg = (LAS float*)(lds + pair * 24576);
    const bf16_t* ZF = (const bf16_t*)(cx.p->ws + OFF_ZF); const bf16_t* DA = (const bf16_t*)(cx.p->ws + OFF_DWA);
    float* STT = (float*)(cx.p->ws + OFF_ST);
    const int NCH = PB ? 16 : 15, NT = 64 * NCH;
    for (int task = cx.bid * 4 + pair; task < NT; task += cx.nb * 4) {
        const int chain = task / NCH, chunk = task - chain * NCH; const int dir = chain & 1, h = (chain >> 1) & 7, b = chain >> 4;
        const bf16_t* DW = (const bf16_t*)(cx.p->ws + (dir ? OFF_DWB : OFF_DWF));
        bf16_t* O = (bf16_t*)(cx.p->ws + (dir ? OFF_OB : OFF_OF));
        const int hc = h * 64 + lane; const int sgn = dir ? -1 : 1;
        const float kkc = cx.p->in[I_KK][layer * 512 + hc], kac = cx.p->in[I_KA][layer * 512 + hc];
        f32x2 S[NR][8];
#pragma unroll
        for (int ii = 0; ii < NR; ++ii)
#pragma unroll
            for (int q = 0; q < 8; ++q) { const int row = rowbase + ii, col = 16 * cg + 2 * q;
                S[ii][q] = (!PB && sub == 1) ? (f32x2){row == col ? 1.f : 0.f, row == col + 1 ? 1.f : 0.f} : (f32x2){0.f, 0.f}; }
        if (PB && chunk > 0) {
            const float* src = STT + ((size_t)(chain * 16 + chunk - 1) * 2) * 4096 + rowbase * 64 + 16 * cg;
#pragma unroll
            for (int ii = 0; ii < NR; ++ii)
#pragma unroll
                for (int q = 0; q < 4; ++q) { const f32x4 v = *(const f32x4*)(src + ii * 64 + q * 4); S[ii][2 * q] = (f32x2){v[0], v[1]}; S[ii][2 * q + 1] = (f32x2){v[2], v[3]}; }
        }
        bf16_t raw[4][5];
        int R0 = tokrow(b, dir, chunk * 528);
#pragma unroll
        for (int t = 0; t < 4; ++t) { const size_t R = (size_t)(R0 + sgn * (sub * 4 + t));
            raw[t][0] = ZF[R * 1536 + hc]; raw[t][1] = ZF[R * 1536 + 512 + hc]; raw[t][2] = ZF[R * 1536 + 1024 + hc]; raw[t][3] = DW[R * 512 + hc]; raw[t][4] = DA[R * 512 + hc]; }
        for (int batch = 0; batch < 66; ++batch) {
            const int Rb0 = R0;
            LAS float* st = stg + (batch & 1) * 3072;
            float kkr[4], nrm[4];
#pragma unroll
            for (int t = 0; t < 4; ++t) {
                const float r = bf2f(raw[t][0]), k = bf2f(raw[t][1]), v = bf2f(raw[t][2]), w = bf2f(raw[t][3]), a = bf2f(raw[t][4]);
                kkr[t] = k * kkc; nrm[t] = kkr[t] * kkr[t];
                LAS float* sb = st + (sub * 4 + t) * 384;
                sb[lane] = w; sb[192 + lane] = k * (1.0f + (a - 1.0f) * kac); sb[256 + lane] = r; sb[320 + lane] = v;
            }
#pragma unroll
            for (int t = 0; t < 4; ++t) nrm[t] = row16_allsum(nrm[t]);
#pragma unroll
            for (int t = 0; t < 4; ++t) {
                const float tot = (rlf(nrm[t], 0) + rlf(nrm[t], 16)) + (rlf(nrm[t], 32) + rlf(nrm[t], 48));
                const float kk = kkr[t] * rsqrtf(tot + 1e-12f); const float a = bf2f(raw[t][4]);
                LAS float* sb = st + (sub * 4 + t) * 384; sb[64 + lane] = kk; sb[128 + lane] = kk * a;
            }
            if (batch < 65) {
                R0 = tokrow(b, dir, chunk * 528 + (batch + 1) * 8);
#pragma unroll
                for (int t = 0; t < 4; ++t) { const size_t R = (size_t)(R0 + sgn * (sub * 4 + t));
                    raw[t][0] = ZF[R * 1536 + hc]; raw[t][1] = ZF[R * 1536 + 512 + hc]; raw[t][2] = ZF[R * 1536 + 1024 + hc]; raw[t][3] = DW[R * 512 + hc]; raw[t][4] = DA[R * 512 + hc]; }
            }
            __syncthreads();
#pragma unroll 4
            for (int t = 0; t < 8; ++t) {
                const LAS float* sb = st + t * 384; float o[NR];
                if (PB) {
                    rwkv_step<NR, true, true>(S, sb, cg, rowbase, o);
                    if (cg < 2) O[(size_t)(Rb0 + sgn * t) * 512 + h * 64 + rowbase + cg] = f2bf(cg == 0 ? o[0] : o[1]);
                } else if (sub == 0) rwkv_step<NR, true, false>(S, sb, cg, rowbase, o);
                else rwkv_step<NR, false, false>(S, sb, cg, rowbase, o);
            }
        }
        if (!PB && (sub == 0 || chunk > 0)) {
            float* d0 = STT + ((size_t)(chain * 16 + chunk) * 2 + sub) * 4096 + rowbase * 64 + 16 * cg;
#pragma unroll
            for (int ii = 0; ii < NR; ++ii)
#pragma unroll
                for (int q = 0; q < 4; ++q) *(f32x4*)(d0 + ii * 64 + q * 4) = (f32x4){S[ii][2 * q][0], S[ii][2 * q][1], S[ii][2 * q + 1][0], S[ii][2 * q + 1][1]};
        }
        __syncthreads();
    }
}
__device__ __forceinline__ void phase_rwkv_prefix(const Ctx& cx, float* lds) {
    const int tid = cx.tid; float* STT = (float*)(cx.p->ws + OFF_ST);
    float* sA = lds; float* sP = lds + 16 * 65;
    for (int task = cx.bid; task < 256; task += cx.nb) {
        const int chain = task >> 2, r0 = (task & 3) * 16;
        __syncthreads();
        { const float* s0 = STT + ((size_t)(chain * 16) * 2) * 4096 + r0 * 64; for (int i = tid; i < 1024; i += 512) sA[(i >> 6) * 65 + (i & 63)] = s0[i]; }
        f32x4 pr[2];
        { const float* pm = STT + ((size_t)(chain * 16 + 1) * 2 + 1) * 4096; pr[0] = *(const f32x4*)(pm + tid * 8); pr[1] = *(const f32x4*)(pm + tid * 8 + 4); }
        const int i = tid >> 5, j0 = (tid & 31) * 2;
        for (int c = 1; c < 15; ++c) {
            float* se = STT + ((size_t)(chain * 16 + c) * 2) * 4096 + r0 * 64;
            __syncthreads();
            *(f32x4*)(sP + tid * 8) = pr[0]; *(f32x4*)(sP + tid * 8 + 4) = pr[1];
            if (c < 14) { const float* pm = STT + ((size_t)(chain * 16 + c + 1) * 2 + 1) * 4096; pr[0] = *(const f32x4*)(pm + tid * 8); pr[1] = *(const f32x4*)(pm + tid * 8 + 4); }
            float a0 = se[i * 64 + j0], a1 = se[i * 64 + j0 + 1];
            __syncthreads();
            for (int k = 0; k < 64; ++k) { const float a = sA[i * 65 + k]; a0 += a * sP[k * 64 + j0]; a1 += a * sP[k * 64 + j0 + 1]; }
            __syncthreads();
            sA[i * 65 + j0] = a0; sA[i * 65 + j0 + 1] = a1; se[i * 64 + j0] = a0; se[i * 64 + j0 + 1] = a1;
        }
    }
}
__device__ __forceinline__ void phase_rwkv_finish(const Ctx& cx, int layer) {
    const int lane = cx.tid & 63, gw = cx.bid * 8 + (cx.tid >> 6), nw = cx.nb * 8;
    const bf16_t* ZF = (const bf16_t*)(cx.p->ws + OFF_ZF); const bf16_t* DA = (const bf16_t*)(cx.p->ws + OFF_DWA); const bf16_t* G = (const bf16_t*)(cx.p->ws + OFF_G);
    const bf16_t* OF = (const bf16_t*)(cx.p->ws + OFF_OF); const bf16_t* OB = (const bf16_t*)(cx.p->ws + OFF_OB); bf16_t* YR = (bf16_t*)(cx.p->ws + OFF_YR);
    const int c0 = lane * 8;
    float ka[8], rk[8], gg[8], gb[8];
#pragma unroll
    for (int j = 0; j < 8; ++j) { ka[j] = cx.p->in[I_KA][layer * 512 + c0 + j]; rk[j] = cx.p->in[I_RK][layer * 512 + c0 + j]; gg[j] = cx.p->in[I_GNG][layer * 512 + c0 + j]; gb[j] = cx.p->in[I_GNB][layer * 512 + c0 + j]; }
    for (int r = gw; r < MT; r += nw) {
        const u32x4 of = *(const u32x4*)(OF + (size_t)r * 512 + c0), ob = *(const u32x4*)(OB + (size_t)r * 512 + c0);
        const u32x4 rr = *(const u32x4*)(ZF + (size_t)r * 1536 + c0), kk = *(const u32x4*)(ZF + (size_t)r * 1536 + 512 + c0), vv = *(const u32x4*)(ZF + (size_t)r * 1536 + 1024 + c0);
        const u32x4 aa = *(const u32x4*)(DA + (size_t)r * 512 + c0), g4 = *(const u32x4*)(G + (size_t)r * 512 + c0);
        const unsigned ofw[4] = {of.x, of.y, of.z, of.w}, obw[4] = {ob.x, ob.y, ob.z, ob.w}, rw[4] = {rr.x, rr.y, rr.z, rr.w}, kw[4] = {kk.x, kk.y, kk.z, kk.w},
                       vw[4] = {vv.x, vv.y, vv.z, vv.w}, aw[4] = {aa.x, aa.y, aa.z, aa.w}, gw4[4] = {g4.x, g4.y, g4.z, g4.w};
        float o[8], vf[8], gf[8]; float s = 0.f, bs = 0.f;
#pragma unroll
        for (int j = 0; j < 4; ++j) {
            o[2 * j] = bflo(ofw[j]) + bflo(obw[j]); o[2 * j + 1] = bfhi(ofw[j]) + bfhi(obw[j]);
            vf[2 * j] = bflo(vw[j]); vf[2 * j + 1] = bfhi(vw[j]); gf[2 * j] = bflo(gw4[j]); gf[2 * j + 1] = bfhi(gw4[j]);
            const float k0 = bflo(kw[j]) * (1.0f + (bflo(aw[j]) - 1.0f) * ka[2 * j]), k1 = bfhi(kw[j]) * (1.0f + (bfhi(aw[j]) - 1.0f) * ka[2 * j + 1]);
            bs += bflo(rw[j]) * k0 * rk[2 * j] + bfhi(rw[j]) * k1 * rk[2 * j + 1];
            s += o[2 * j] + o[2 * j + 1];
        }
        s += swz<1>(s); s += swz<2>(s); s += swz<4>(s);
        bs += swz<1>(bs); bs += swz<2>(bs); bs += swz<4>(bs);
        const float mean = s * (1.0f / 64.0f); float q = 0.f;
#pragma unroll
        for (int j = 0; j < 8; ++j) { o[j] -= mean; q += o[j] * o[j]; }
        q += swz<1>(q); q += swz<2>(q); q += swz<4>(q);
        const float rstd = rsqrtf(q * (1.0f / 64.0f) + 64e-5f);
        float y[8];
#pragma unroll
        for (int j = 0; j < 8; ++j) y[j] = (o[j] * rstd * gg[j] + gb[j] + bs * vf[j]) * gf[j];
        u32x4 w; w.x = pk2(y[0], y[1]); w.y = pk2(y[2], y[3]); w.z = pk2(y[4], y[5]); w.w = pk2(y[6], y[7]);
        *(u32x4*)(YR + (size_t)r * 512 + c0) = w;
    }
}

template <int ph> __device__ __forceinline__ void run_phase_t(const Ctx& cx, unsigned char* shm) {
    LAS unsigned char* lds = (LAS unsigned char*)shm;
    float* ldf = (float*)shm;
    char* ws = cx.p->ws; char* wb = ws + OFF_WB; float* mods = (float*)(ws + OFF_MODS);
    if (ph == 0) { phase_ada(cx, ldf); __syncthreads(); phase_cv(cx, 0, ldf); if (PROBE == 8) { __syncthreads(); phase_ada(cx, ldf); __syncthreads(); phase_cv(cx, 0, ldf); } return; }
    if (ph == 1) { phase_row<1 | 16 | 4>(cx, MT, nullptr, nullptr, mods + 0 * 1024, (bf16_t*)(ws + OFF_U)); return; }
    const int l = (ph - 2) / 16, s = (ph - 2) % 16;
    const float* lm = mods + (size_t)l * 5 * 9216;
    const float* lng = cx.p->in[I_LNG] + (size_t)l * 3 * 1024; const float* lnb = cx.p->in[I_LNB] + (size_t)l * 3 * 1024;
    const int Mlate = (l == 1) ? ML : MT;
    switch (s) {
    case 0: { EpiSwiglu E{(bf16_t*)(ws + OFF_ACT)}; run_gemm<true>(cx, lds, ws + OFF_U, 1024, wb + WB_W1A, 1024, MT, 5632, 1024, E); if (PROBE == 2) run_gemm<true>(cx, lds, ws + OFF_U, 1024, wb + WB_W1A, 1024, MT, 5632, 1024, E); } break;
    case 1: { EpiH E{(bf16_t*)(ws + OFF_H)}; run_gemm<true>(cx, lds, ws + OFF_ACT, DFF, wb + WB_W2A, DFF, MT, 1024, DFF, E); } break;
    case 2: if (l == 0) phase_row<1 | 8 | 2 | 4>(cx, MT, lng, lnb, lm + 3 * 1024, (bf16_t*)(ws + OFF_U), lm + 2 * 1024, 0.5f, (const bf16_t*)(ws + OFF_H));
            else phase_row<8 | 2 | 4>(cx, MT, lng, lnb, lm + 3 * 1024, (bf16_t*)(ws + OFF_U), lm + 2 * 1024, 0.5f, (const bf16_t*)(ws + OFF_H)); break;
    case 3: { EpiSplit E{ws}; run_gemm<true>(cx, lds, ws + OFF_U, 1024, wb + WB_WIN, 1024, MT, 3328, 1024, E); } break;
    case 4: phase_ap(cx, l); break;
    case 5: {
        if (PROBE == 7) phase_attn(cx, l, (bf16_t*)(ws + OFF_LIN));
        phase_attn(cx, l, (bf16_t*)(ws + OFF_QB));
        __syncthreads();
        phase_s5(cx, l, lds);
        __syncthreads();
        if (PROBE == 3) { phase_s5(cx, l, lds); __syncthreads(); }
        EpiLora E{ws, cx.p->in[I_W0] + (size_t)l * 1024, cx.p->in[I_A0] + (size_t)l * 512};
        run_gemm<true>(cx, lds, ws + OFF_AP, 384, wb + WB_LORA, 384, MT, 2048, 384, E);
    } break;
    case 6: phase_rwkv_scan<false>(cx, l, lds); if (PROBE == 1) phase_rwkv_scan<false>(cx, l, lds); phase_s5gelu(cx, l); break;
    case 7: {
        phase_rwkv_prefix(cx, ldf);
        __syncthreads();
        EpiGlu E{(const bf16_t*)(ws + OFF_ZS), (bf16_t*)(ws + OFF_YS), cx.p->in[I_GLUB] + (size_t)l * 512};
        run_gemm<true>(cx, lds, ws + OFF_ZS, 512, wb + WB_GLU, 512, MT, 512, 512, E);
    } break;
    case 8: phase_rwkv_scan<true>(cx, l, lds); if (PROBE == 1) phase_rwkv_scan<true>(cx, l, lds); break;
    case 9: phase_rwkv_finish(cx, l); phase_row<4>(cx, Mlate, nullptr, nullptr, lm + 3 * 1024, (bf16_t*)(ws + OFF_U2));
        if (PROBE == 5) phase_row<4>(cx, Mlate, nullptr, nullptr, lm + 3 * 1024, (bf16_t*)(ws + OFF_U2)); if (PROBE == 6) phase_rwkv_finish(cx, l); break;
    case 10: {
        const char* Y[3] = {ws + OFF_QB, ws + OFF_YR, ws + OFF_YS};
#pragma unroll
        for (int i = 0; i < 3; ++i) {
            { EpiGate E{(bf16_t*)(ws + OFF_GB)}; run_gemm<true>(cx, lds, ws + OFF_U2, 1024, wb + WB_WGT + (size_t)i * 1024 * 1024 * 2, 1024, Mlate, 1024, 1024, E); }
            { EpiBranch E{(const bf16_t*)(ws + OFF_GB), (bf16_t*)(ws + OFF_MG), i == 0}; run_gemm<true>(cx, lds, Y[i], 512, wb + WB_BP + (size_t)i * 1024 * 512 * 2, 512, Mlate, 1024, 512, E); }
        }
    } break;
    case 11: { EpiH E{(bf16_t*)(ws + OFF_H)}; run_gemm<true>(cx, lds, ws + OFF_MG, 1024, wb + WB_WOUT, 1024, Mlate, 1024, 1024, E); } break;
    case 12: phase_row<8 | 2 | 4>(cx, Mlate, lng + 1024, lnb + 1024, lm + 6 * 1024, (bf16_t*)(ws + OFF_U), lm + 5 * 1024, 1.0f, (const bf16_t*)(ws + OFF_H)); break;
    case 13: { EpiSwiglu E{(bf16_t*)(ws + OFF_ACT)}; run_gemm<true>(cx, lds, ws + OFF_U, 1024, wb + WB_W1B, 1024, Mlate, 5632, 1024, E); } break;
    case 14: { EpiH E{(bf16_t*)(ws + OFF_H)}; run_gemm<true>(cx, lds, ws + OFF_ACT, DFF, wb + WB_W2B, DFF, Mlate, 1024, DFF, E); } break;
    case 15:
        if (l == 0) { phase_row<8 | 2 | 4>(cx, MT, lng + 2048, lnb + 2048, mods + (size_t)5 * 9216, (bf16_t*)(ws + OFF_U), lm + 8 * 1024, 0.5f, (const bf16_t*)(ws + OFF_H)); __syncthreads(); phase_cv(cx, 1, ldf); }
        else phase_row<8 | 2>(cx, ML, lng + 2048, lnb + 2048, nullptr, nullptr, lm + 8 * 1024, 0.5f, (const bf16_t*)(ws + OFF_H));
        break;
    }
}


#define XB_TMO      128
#define XB_XCNT(j)  (256  + 64 * (j))
#define XB_XSUB(j)  (1280 + 64 * (j))
#define XB_XGEN(j)  (2304 + 64 * (j))
#define XB_TOP      3328
#define XB_TOPGEN   3392
#define XCD_BAR_WORDS 3456
#define XB_SPIN_CAP (1u << 18)
DI unsigned xb_ld(unsigned* p) { return __hip_atomic_load(p, __ATOMIC_RELAXED, __HIP_MEMORY_SCOPE_AGENT); }
DI unsigned xb_add(unsigned* p, unsigned v) { return __hip_atomic_fetch_add(p, v, __ATOMIC_RELAXED, __HIP_MEMORY_SCOPE_AGENT); }
DI unsigned xb_xcc_id() { return (unsigned)__builtin_amdgcn_s_getreg((3 << 11) | 20) & 0xFu; }
#define XB_SPIN(cond, bar) do { unsigned _sp = 0; while (cond) { __builtin_amdgcn_s_sleep(1); \
    if ((++_sp & 255u) == 0u) { if (xb_ld(&(bar)[XB_TMO])) break; if (_sp > XB_SPIN_CAP) { atomicAdd(&(bar)[XB_TMO], 1u); break; } } } } while (0)
struct XcdBarrier { unsigned* bar; unsigned x; volatile LAS unsigned* st; };
DI XcdBarrier xcd_barrier_post(unsigned* bar, volatile LAS unsigned* st) {
    XcdBarrier b; b.bar = bar; b.x = xb_xcc_id(); b.st = st;
    if (threadIdx.x == 0) (void)xb_add(&bar[XB_XCNT(b.x)], 1u);
    return b;
}
DI void xcd_barrier_complete(unsigned* bar, unsigned x, unsigned& nloc, unsigned& nx) {
    const unsigned G = gridDim.x * gridDim.y * gridDim.z;
    unsigned sum, cnt, mine, sp = 0u;
    for (;;) {
        sum = 0u; cnt = 0u; mine = 0u;
#pragma unroll
        for (unsigned j = 0; j < 16; ++j) { const unsigned c = xb_ld(&bar[XB_XCNT(j)]); sum += c; cnt += (c > 0u) ? 1u : 0u; mine = (j == x) ? c : mine; }
        if (sum == G) break;
        __builtin_amdgcn_s_sleep(1);
        if ((++sp & 255u) == 0u) { if (xb_ld(&bar[XB_TMO])) break; if (sp > XB_SPIN_CAP) { atomicAdd(&bar[XB_TMO], 1u); break; } }
    }
    nloc = mine > 0u ? mine : 1u; nx = cnt > 0u ? cnt : 1u;
}
DI void xcd_barrier(const XcdBarrier& b) {
    asm volatile("s_waitcnt vmcnt(0)" ::: "memory");
    __syncthreads();
    if (threadIdx.x == 0) {
        unsigned* bar = b.bar;
        __builtin_amdgcn_s_waitcnt(0);
        unsigned nloc = b.st[0], nx = b.st[1];
        if (nloc == 0u) { xcd_barrier_complete(bar, b.x, nloc, nx); b.st[0] = nloc; b.st[1] = nx; }
        const unsigned old = xb_add(&bar[XB_XSUB(b.x)], 1u);
        const unsigned gen = old / nloc;
        if (old + 1u == (gen + 1u) * nloc) {
            __builtin_amdgcn_fence(__ATOMIC_RELEASE, "agent");
            asm volatile("s_waitcnt vmcnt(0)" ::: "memory");
            const unsigned og = xb_add(&bar[XB_TOP], 1u);
            const unsigned tg = og / nx;
            if (og + 1u == (tg + 1u) * nx) xb_add(&bar[XB_TOPGEN], 1u);
            else XB_SPIN(xb_ld(&bar[XB_TOPGEN]) == tg, bar);
            __builtin_amdgcn_fence(__ATOMIC_ACQUIRE, "agent");
            xb_add(&bar[XB_XGEN(b.x)], 1u);
            asm volatile("s_waitcnt vmcnt(0)" ::: "memory");
        } else {
            XB_SPIN(xb_ld(&bar[XB_XGEN(b.x)]) == gen, bar);
            __builtin_amdgcn_fence(__ATOMIC_ACQUIRE, "agent");
            asm volatile("s_waitcnt vmcnt(0)" ::: "memory");
        }
    }
    __syncthreads();
}
DI Ctx mk_ctx() {
    Ctx cx; cx.p = (PP)__builtin_amdgcn_kernarg_segment_ptr(); cx.tid = threadIdx.x; cx.bid = blockIdx.x; cx.nb = gridDim.x;
    asm volatile("" : "+s"(cx.p), "+v"(cx.tid), "+s"(cx.bid), "+s"(cx.nb));
    return cx;
}
#define PH_RUN(N) { const Ctx cx = mk_ctx(); run_phase_t<N>(cx, shm); if (N + 1 < NPHASE) { if (N == 0) grid.sync(); else xcd_barrier(xb); } }
#if ONE_LAUNCH
__global__ void __launch_bounds__(512, 2) mega(Params p_) {
    extern __shared__ __attribute__((aligned(16))) unsigned char shm[];
    cg::grid_group grid = cg::this_grid();
    volatile LAS unsigned* xst = (volatile LAS unsigned*)((LAS unsigned char*)shm + 131072);
    if (threadIdx.x < 4) xst[threadIdx.x] = 0u;
    __syncthreads();
    const XcdBarrier xb = xcd_barrier_post((unsigned*)(((const Params*)&p_)->ws + OFF_BAR), xst);
    PH_RUN(0) PH_RUN(1) PH_RUN(2) PH_RUN(3) PH_RUN(4) PH_RUN(5) PH_RUN(6) PH_RUN(7) PH_RUN(8) PH_RUN(9) PH_RUN(10) PH_RUN(11)
    PH_RUN(12) PH_RUN(13) PH_RUN(14) PH_RUN(15) PH_RUN(16) PH_RUN(17) PH_RUN(18) PH_RUN(19) PH_RUN(20) PH_RUN(21) PH_RUN(22)
    PH_RUN(23) PH_RUN(24) PH_RUN(25) PH_RUN(26) PH_RUN(27) PH_RUN(28) PH_RUN(29) PH_RUN(30) PH_RUN(31) PH_RUN(32) PH_RUN(33)
}
#else
template <int PH> __global__ void __launch_bounds__(512, 2) k_ph(Params p_) {
    extern __shared__ __attribute__((aligned(16))) unsigned char shm[];
    Ctx cx; cx.p = (PP)__builtin_amdgcn_kernarg_segment_ptr(); cx.tid = threadIdx.x; cx.bid = blockIdx.x; cx.nb = gridDim.x;
    run_phase_t<PH>(cx, shm);
}
#endif
constexpr size_t kLds = 131072 + 16;
#if !ONE_LAUNCH
template <int PH> static void set_attr_all() { if constexpr (PH < NPHASE) { (void)hipFuncSetAttribute((const void*)k_ph<PH>, hipFuncAttributeMaxDynamicSharedMemorySize, (int)kLds); set_attr_all<PH + 1>(); } }
template <int PH> static void launch_all(const Params& p, hipStream_t st) { if constexpr (PH < NPHASE) { k_ph<PH><<<256, 512, kLds, st>>>(p); launch_all<PH + 1>(p, st); } }
#endif

extern "C" void kernel_launch(void* const* d_in, const int* in_sizes, int n_in, void* d_out, int out_size, void* d_ws, size_t ws_size, hipStream_t stream) {
    static int inited = 0;
    Params p{};
    for (int i = 0; i < 35; ++i) p.in[i] = (const float*)d_in[i];
    p.out = (float*)d_out; p.ws = (char*)d_ws;
#if ONE_LAUNCH
    if (!inited) { (void)hipFuncSetAttribute((const void*)mega, hipFuncAttributeMaxDynamicSharedMemorySize, (int)kLds); inited = 1; }
    (void)hipMemsetAsync((char*)d_ws + OFF_BAR, 0, XCD_BAR_WORDS * 4, stream);
    void* args[] = {&p};
    hipError_t e = hipLaunchCooperativeKernel((const void*)mega, dim3(256), dim3(512), args, kLds, stream);
    if (e != hipSuccess) fprintf(stderr, "cooperative launch failed: %s\n", hipGetErrorString(e));
#else
    if (!inited) { set_attr_all<0>(); inited = 1; }
    launch_all<0>(p, stream);
#endif
}
```

```cpp
#include <hip/hip_runtime.h>
#include <hip/hip_cooperative_groups.h>
#include <stdint.h>
#include <stdio.h>
namespace cg = cooperative_groups;

#define LAS __attribute__((address_space(3)))
#define DI __device__ __forceinline__
typedef unsigned short bf16_t;
typedef short bf16x8 __attribute__((ext_vector_type(8)));
typedef float f32x4 __attribute__((ext_vector_type(4)));
typedef float f32x2 __attribute__((ext_vector_type(2)));
typedef unsigned u32x4 __attribute__((ext_vector_type(4)));
typedef unsigned u32x2 __attribute__((ext_vector_type(2)));

#ifndef PROBE
#define PROBE 0
#endif
#ifndef ONE_LAUNCH
#define ONE_LAUNCH 1
#endif

constexpr int ML = 32768, MC = 1024, MT = 33792, DM = 1024, DFF = 2816;
constexpr float ALPHA = 1.41421356237f;
constexpr float LOG2E = 1.44269504089f;
constexpr int NPHASE = 34;

constexpr size_t S512 = (size_t)MT * 512 * 2;
constexpr size_t OFF_MODS = 0;
constexpr size_t OFF_XC = 368640;
constexpr size_t OFF_WB = OFF_XC + 4194304;
constexpr size_t WB_W1A = 0, WB_W2A = 11534336, WB_W1B = 17301504, WB_W2B = 28835840, WB_WIN = 34603008, WB_WGT = 41418752,
                 WB_BP = 47710208, WB_WOUT = 50855936, WB_GLU = 52953088, WB_LORA = 53477376, WB_END = 55050240;
constexpr size_t OFF_POOL = OFF_WB + WB_END;
constexpr size_t P0 = OFF_POOL, P1 = P0 + 2 * S512, P2 = P1 + S512, P3 = P2 + S512, P4 = P3 + 3 * S512, P5 = P4 + 3 * S512, P7 = P5 + S512, PEND = P7 + 2 * S512;
constexpr size_t OFF_U = P0, OFF_ACT = P0 + 2 * S512;
constexpr size_t OFF_AP = P0, OFF_KR = P0 + 25952256, OFF_VT = P0 + S512, OFF_ST = P0, OFF_YS = P0 + S512, OFF_YR = P0;
constexpr size_t OFF_QB = P1, OFF_ZS = P2, OFF_ZR = P3, OFF_DWF = P3, OFF_DWB = P3 + S512, OFF_DWA = P3 + 2 * S512, OFF_U2 = P3;
constexpr size_t OFF_ZF = P4, OFF_MG = P4, OFF_LIN = P5, OFF_G = P5, OFF_KVB = P7, OFF_YF = P7, OFF_YB = P7 + S512, OFF_OF = P7, OFF_OB = P7 + S512;
constexpr size_t OFF_GB = P7, OFF_H = P7;
constexpr size_t OFF_BAR = PEND;
static_assert(PEND + 16384 <= (size_t)512 * 1024 * 1024, "workspace");

struct Params {
    const float* in[35];
    float* out;
    char* ws;
};
typedef const __attribute__((address_space(4))) Params* PP;
struct Ctx { PP p; int tid, bid, nb; };
enum { I_X = 0, I_C, I_CTX, I_CCTX, I_WADA, I_BADA, I_LNG, I_LNB, I_FWIN, I_FWOUT, I_WIN, I_SINK, I_MU, I_W0, I_W2, I_A0, I_A2, I_G2, I_KK, I_KA, I_RK,
       I_GNG, I_GNB, I_SARE, I_SAIM, I_SLOG, I_SBRE, I_SBIM, I_SCRE, I_SCIM, I_SD, I_GLUW, I_GLUB, I_BP, I_WOUT };

typedef __bf16 hwbf16x2 __attribute__((ext_vector_type(2)));
DI unsigned pk2(float lo, float hi) { const f32x2 v = {lo, hi}; return __builtin_bit_cast(unsigned, __builtin_convertvector(v, hwbf16x2)); }
DI bf16_t f2bf(float f) { return (bf16_t)(pk2(f, 0.f) & 0xFFFFu); }
DI float bf2f(bf16_t b) { return __uint_as_float(((unsigned)b) << 16); }

DI float bflo(unsigned w) { return __uint_as_float(w << 16); }
DI float bfhi(unsigned w) { return __uint_as_float(w & 0xFFFF0000u); }
DI float sigm(float x) { return __builtin_amdgcn_rcpf(1.0f + __expf(-x)); }
template <int M> DI float swz(float v) { return __builtin_bit_cast(float, __builtin_amdgcn_ds_swizzle(__builtin_bit_cast(int, v), (M << 10) | 0x1f)); }
DI float wsum(float v) {
    v += swz<1>(v); v += swz<2>(v); v += swz<4>(v); v += swz<8>(v); v += swz<16>(v);
    return __builtin_bit_cast(float, __builtin_amdgcn_readlane(__builtin_bit_cast(int, v), 0)) + __builtin_bit_cast(float, __builtin_amdgcn_readlane(__builtin_bit_cast(int, v), 32));
}
template <int CTRL> DI float dppf(float x) { return __builtin_bit_cast(float, __builtin_amdgcn_mov_dpp(__builtin_bit_cast(int, x), CTRL, 0xF, 0xF, true)); }
DI float row16_allsum(float x) { x += dppf<0x128>(x); x += dppf<0x124>(x); x += dppf<0x122>(x); x += dppf<0x121>(x); return x; }
DI float rlf(float x, int l) { return __builtin_bit_cast(float, __builtin_amdgcn_readlane(__builtin_bit_cast(int, x), l)); }
DI float xor32(int lane, float v) { return __builtin_bit_cast(float, __builtin_amdgcn_ds_bpermute((lane ^ 32) << 2, __builtin_bit_cast(int, v))); }
DI float* xrow(const Ctx& cx, int r) { return r < ML ? cx.p->out + (size_t)r * DM : (float*)(cx.p->ws + OFF_XC) + (size_t)(r - ML) * DM; }
DI int tokrow(int b, int dir, int pos) {
    if (pos < 256) return ML + b * 256 + (dir ? 255 - pos : pos);
    const int t = pos - 256; return b * 8192 + (dir ? 8191 - t : t);
}
DI void wave_lds_sync() { asm volatile("s_waitcnt lgkmcnt(0)" ::: "memory"); __builtin_amdgcn_wave_barrier(); }

namespace pg8 {
constexpr int BM = 256, BK = 64, HALF = 128, HTB = HALF * BK * 2, STAGE_BYTES = 8 * HTB;
DI int lds_byte(int r, int c) { const int st = (r >> 4) * 2 + (c >> 5), rr = r & 15, cc = c & 31, ob = rr * 64 + cc * 2; return st * 1024 + (ob ^ (((ob >> 9) & 1) << 5)); }
DI void stage_rc(int b, int& R, int& C) { const int st = b / 1024, sb = b % 1024, swz = sb ^ (((sb >> 9) & 1) << 5); R = (st >> 1) * 16 + swz / 64; C = (st & 1) * 32 + (swz % 64) / 2; }
DI int perm32(int rho) { const int n = rho >> 4, i = rho & 15; return 8 * (i >> 2) + 4 * n + (i & 3); }

struct Unit { const char* A; const char* B; unsigned lda2, ldb2; int nt; int pm, pn, tag; };
DI const char* rfl_ptr(const char* p) { const unsigned long long v = (unsigned long long)p; const unsigned lo = __builtin_amdgcn_readfirstlane((unsigned)v), hi = __builtin_amdgcn_readfirstlane((unsigned)(v >> 32)); return (const char*)(((unsigned long long)hi << 32) | lo); }
DI void uniformize(Unit& u) { u.A = rfl_ptr(u.A); u.B = rfl_ptr(u.B); u.lda2 = __builtin_amdgcn_readfirstlane(u.lda2); u.ldb2 = __builtin_amdgcn_readfirstlane(u.ldb2); u.nt = __builtin_amdgcn_readfirstlane(u.nt);
    u.pm = __builtin_amdgcn_readfirstlane(u.pm); u.pn = __builtin_amdgcn_readfirstlane(u.pn); u.tag = __builtin_amdgcn_readfirstlane(u.tag); }

DI void tile_of(int wgid, int nM, int nN, int& pm, int& pn) {
    const int nwg = nM * nN; const int q = nwg / 8, r = nwg % 8, xcd = wgid % 8, off = wgid / 8;
    wgid = (xcd < r ? xcd * (q + 1) : r * (q + 1) + (xcd - r) * q) + off;
    const int nig = 8 * nN, gid = wgid / nig, fm = gid * 8, gsz = (nM - fm) < 8 ? (nM - fm) : 8;
    pm = fm + ((wgid % nig) % gsz); pn = (wgid % nig) / gsz;
}
struct PlainSched {
    const char* A; const char* B; unsigned lda2, ldb2; int nt, nM, nN, G, c;
    DI bool next(int i, Unit& u) const {
        const long L = (long)i * G + c; if (L >= (long)nM * nN) return false;
        tile_of((int)L, nM, nN, u.pm, u.pn);
        u.A = A + (size_t)u.pm * 256 * lda2; u.B = B + (size_t)u.pn * 256 * ldb2; u.lda2 = lda2; u.ldb2 = ldb2; u.nt = nt; u.tag = 0; return true;
    }
};

template <bool PERM, class Sched, class Epi>
DI void gemm_phase(const Ctx& cx, LAS unsigned char* lds, const Sched& S, const Epi& E) {
    const int tid = cx.tid, wid = __builtin_amdgcn_readfirstlane(tid >> 6), lane = tid & 63, wr = wid >> 2, wc = wid & 3, fr = lane & 15, fq = lane >> 4;
    int Rr[2], Rb[2], Cc[2];
#pragma unroll
    for (int i = 0; i < 2; ++i) { int R, C; stage_rc(tid * 16 + i * 8192, R, C); Rr[i] = R; Rb[i] = PERM ? ((R & ~31) + perm32(R & 31)) : R; Cc[i] = C * 2; }
    const size_t kstep = (size_t)(BK * 2);
    const unsigned ldsw = (unsigned)wid * 1024u;
    const int aoff = lds_byte(wr * 64 + fr, fq * 8), boff = lds_byte(wc * 32 + fr, fq * 8);
#define PG8_SA(b, h) (((b) * 2 + (h)) * HTB)
#define PG8_SB(b, h) ((4 + (b) * 2 + (h)) * HTB)
#define PG8_STAGEA(bufoff, gbase, ld2) do { _Pragma("unroll") for (int _i = 0; _i < 2; ++_i) \
        __builtin_amdgcn_global_load_lds((const unsigned*)((const char*)(gbase) + ((unsigned)Rr[_i] * (ld2) + Cc[_i])), (LAS unsigned*)(lds + (bufoff) + ldsw + _i * 8192), 16, 0, 0); } while (0)
#define PG8_STAGEB(bufoff, gbase, ld2) do { _Pragma("unroll") for (int _i = 0; _i < 2; ++_i) \
        __builtin_amdgcn_global_load_lds((const unsigned*)((const char*)(gbase) + ((unsigned)Rb[_i] * (ld2) + Cc[_i])), (LAS unsigned*)(lds + (bufoff) + ldsw + _i * 8192), 16, 0, 0); } while (0)
#define PG8_LDA(dst, b, h) do { _Pragma("unroll") for (int m = 0; m < 4; ++m) _Pragma("unroll") for (int k = 0; k < 2; ++k) dst[m][k] = *(const LAS bf16x8*)(lds + PG8_SA(b, h) + aoff + m * 2048 + k * 1024); } while (0)
#define PG8_LDB(dst, b, h) do { _Pragma("unroll") for (int n = 0; n < 2; ++n) _Pragma("unroll") for (int k = 0; k < 2; ++k) dst[n][k] = *(const LAS bf16x8*)(lds + PG8_SB(b, h) + boff + n * 2048 + k * 1024); } while (0)
#define PG8_MMA(ai, bj, At, Bt) do { __builtin_amdgcn_s_setprio(1); _Pragma("unroll") for (int m = 0; m < 4; ++m) _Pragma("unroll") for (int n = 0; n < 2; ++n) _Pragma("unroll") for (int k = 0; k < 2; ++k) \
        acc[ai][bj][m][n] = __builtin_amdgcn_mfma_f32_16x16x32_bf16(Bt[n][k], At[m][k], acc[ai][bj][m][n], 0, 0, 0); __builtin_amdgcn_s_setprio(0); } while (0)
#define PG8_WAIT_V(n) asm volatile("s_waitcnt vmcnt(" #n ")" ::: "memory")
#define PG8_WAIT_L(n) asm volatile("s_waitcnt lgkmcnt(" #n ")" ::: "memory")
#define PG8_BAR __builtin_amdgcn_s_barrier()
#define PG8_SCHED __builtin_amdgcn_sched_barrier(0)
    Unit cur, nxt; int ui = 0;
    if (!S.next(0, cur)) return;
    f32x4 acc[2][2][4][2];
#pragma unroll
    for (int a = 0; a < 2; ++a)
#pragma unroll
        for (int b = 0; b < 2; ++b)
#pragma unroll
            for (int m = 0; m < 4; ++m)
#pragma unroll
                for (int n = 0; n < 2; ++n) acc[a][b][m][n] = (f32x4){0.f, 0.f, 0.f, 0.f};
    bf16x8 At[4][2], B0[2][2], B1[2][2];
    const char* cA = cur.A; const char* cB = cur.B;
    unsigned clA = cur.lda2, clB = cur.ldb2; size_t chA = (size_t)HALF * cur.lda2, chB = (size_t)HALF * cur.ldb2;
    PG8_STAGEB(PG8_SB(0, 0), cB, clB); PG8_STAGEA(PG8_SA(0, 0), cA, clA); PG8_STAGEB(PG8_SB(0, 1), cB + chB, clB); PG8_STAGEA(PG8_SA(0, 1), cA + chA, clA);
    if (wr == 1) PG8_BAR;
    PG8_WAIT_V(4); PG8_BAR;
    PG8_STAGEB(PG8_SB(1, 0), cB + kstep, clB); PG8_STAGEA(PG8_SA(1, 0), cA + kstep, clA); PG8_STAGEB(PG8_SB(1, 1), cB + chB + kstep, clB);
    PG8_WAIT_V(6); PG8_BAR;
    for (;;) {
        const bool has_next = S.next(ui + 1, nxt);
        const char* nA = has_next ? nxt.A : cA; const char* nB = has_next ? nxt.B : cB;
        const unsigned nlda = has_next ? nxt.lda2 : cur.lda2, nldb = has_next ? nxt.ldb2 : cur.ldb2;
        const size_t nhA = (size_t)HALF * nlda, nhB = (size_t)HALF * nldb;
        const int nt = cur.nt;
        for (int t = 0; t < nt; t += 2) {
            const bool last = (t == nt - 2);
            const char* a1 = cA + (size_t)(t + 1) * kstep;
            const char* a2 = last ? nA : cA + (size_t)(t + 2) * kstep; const char* b2 = last ? nB : cB + (size_t)(t + 2) * kstep;
            const char* a3 = a2 + kstep; const char* b3 = b2 + kstep;
            const size_t hA2 = last ? nhA : chA, hB2 = last ? nhB : chB; const unsigned lA2 = last ? nlda : clA, lB2 = last ? nldb : clB;
            PG8_LDB(B0, 0, 0); PG8_SCHED; PG8_LDA(At, 0, 0); PG8_STAGEA(PG8_SA(1, 1), a1 + chA, clA);
            PG8_WAIT_L(8); PG8_BAR; PG8_WAIT_L(0); PG8_MMA(0, 0, At, B0); PG8_BAR; PG8_SCHED;
            PG8_LDB(B1, 0, 1); PG8_STAGEB(PG8_SB(0, 0), b2, lB2);
            PG8_BAR; PG8_WAIT_L(0); PG8_MMA(0, 1, At, B1); PG8_BAR;
            PG8_LDA(At, 0, 1); PG8_STAGEA(PG8_SA(0, 0), a2, lA2);
            PG8_BAR; PG8_WAIT_L(0); PG8_MMA(1, 0, At, B0); PG8_BAR; PG8_SCHED;
            PG8_STAGEB(PG8_SB(0, 1), b2 + hB2, lB2);
            PG8_WAIT_V(6); PG8_BAR; PG8_MMA(1, 1, At, B1); PG8_BAR;
            PG8_LDB(B0, 1, 0); PG8_SCHED; PG8_LDA(At, 1, 0); PG8_STAGEA(PG8_SA(0, 1), a2 + hA2, lA2);
            PG8_WAIT_L(8); PG8_BAR; PG8_WAIT_L(0); PG8_MMA(0, 0, At, B0); PG8_BAR; PG8_SCHED;
            PG8_LDB(B1, 1, 1); PG8_STAGEB(PG8_SB(1, 0), b3, lB2);
            PG8_BAR; PG8_WAIT_L(0); PG8_MMA(0, 1, At, B1); PG8_BAR;
            PG8_LDA(At, 1, 1); PG8_STAGEA(PG8_SA(1, 0), a3, lA2);
            PG8_BAR; PG8_WAIT_L(0); PG8_MMA(1, 0, At, B0); PG8_BAR; PG8_SCHED;
            PG8_STAGEB(PG8_SB(1, 1), b3 + hB2, lB2);
            PG8_WAIT_V(6); PG8_BAR; PG8_MMA(1, 1, At, B1); PG8_BAR;
        }
        E(acc, cur, wr, wc, fr, fq);
        if (!has_next) break;
#pragma unroll
        for (int a = 0; a < 2; ++a)
#pragma unroll
            for (int b = 0; b < 2; ++b)
#pragma unroll
                for (int m = 0; m < 4; ++m)
#pragma unroll
                    for (int n = 0; n < 2; ++n) acc[a][b][m][n] = (f32x4){0.f, 0.f, 0.f, 0.f};
        cur = nxt; cA = nA; cB = nB; chA = nhA; chB = nhB; clA = nlda; clB = nldb;
        ++ui;
    }
    PG8_WAIT_V(0);
    if (wr == 0) PG8_BAR;
    PG8_BAR;
#undef PG8_SA
#undef PG8_SB
#undef PG8_STAGEA
#undef PG8_STAGEB
#undef PG8_LDA
#undef PG8_LDB
#undef PG8_MMA
#undef PG8_WAIT_V
#undef PG8_WAIT_L
#undef PG8_BAR
#undef PG8_SCHED
}
}
using pg8::Unit;
typedef const f32x4 (&AccRef)[2][2][4][2];

template <bool PERM, class Epi>
DI void run_gemm(const Ctx& cx, LAS unsigned char* lds, const void* A, int lda, const void* Bt, int ldb, int M, int N, int K, const Epi& E) {
    pg8::PlainSched S; S.A = (const char*)A; S.B = (const char*)Bt; S.lda2 = lda * 2; S.ldb2 = ldb * 2; S.nt = K / 64; S.nM = M / 256; S.nN = N / 256; S.G = cx.nb; S.c = cx.bid;
    pg8::gemm_phase<PERM>(cx, lds, S, E);
}

DI void store8(bf16_t* dst, f32x4 a, f32x4 b) { u32x4 w; w.x = pk2(a[0], a[1]); w.y = pk2(a[2], a[3]); w.z = pk2(b[0], b[1]); w.w = pk2(b[2], b[3]); *(u32x4*)dst = w; }
struct EpiSwiglu {
    bf16_t* act;
    DI void operator()(AccRef acc, const Unit& u, int wr, int wc, int fr, int fq) const {
        const int row0 = u.pm * 256 + wr * 64 + fr, col0 = u.pn * 128 + wc * 32 + 8 * fq;
#pragma unroll
        for (int ai = 0; ai < 2; ++ai)
#pragma unroll
            for (int m = 0; m < 4; ++m) {
                float v[8];
#pragma unroll
                for (int n = 0; n < 2; ++n)
#pragma unroll
                    for (int j = 0; j < 4; ++j) { const float g = acc[ai][0][m][n][j], up = acc[ai][1][m][n][j]; v[n * 4 + j] = g * sigm(g) * up; }
                u32x4 w; w.x = pk2(v[0], v[1]); w.y = pk2(v[2], v[3]); w.z = pk2(v[4], v[5]); w.w = pk2(v[6], v[7]);
                *(u32x4*)(act + (size_t)(row0 + ai * 128 + m * 16) * DFF + col0) = w;
            }
    }
};
struct EpiH {
    bf16_t* h;
    DI void operator()(AccRef acc, const Unit& u, int wr, int wc, int fr, int fq) const {
        const int row0 = u.pm * 256 + wr * 64 + fr, col0 = u.pn * 256 + wc * 32 + 8 * fq;
#pragma unroll
        for (int ai = 0; ai < 2; ++ai)
#pragma unroll
            for (int m = 0; m < 4; ++m)
#pragma unroll
                for (int bj = 0; bj < 2; ++bj) store8(h + (size_t)(row0 + ai * 128 + m * 16) * 1024 + col0 + bj * 128, acc[ai][bj][m][0], acc[ai][bj][m][1]);
    }
};
struct EpiResid {
    float* xl; float* xc; const float* gate_base; float coef;
    DI void operator()(AccRef acc, const Unit& u, int wr, int wc, int fr, int fq) const {
        const int row0 = u.pm * 256 + wr * 64 + fr, col0 = u.pn * 256 + wc * 32 + 4 * fq;
        const int mi = (u.pm * 256 < ML) ? ((u.pm * 256) >> 13) : 4;
        const float* gate = gate_base + (size_t)mi * 9216;
        f32x4 gv[2][2];
#pragma unroll
        for (int bj = 0; bj < 2; ++bj)
#pragma unroll
            for (int n = 0; n < 2; ++n) gv[bj][n] = *(const f32x4*)(gate + col0 + bj * 128 + n * 16) * coef;
#pragma unroll
        for (int ai = 0; ai < 2; ++ai)
#pragma unroll
            for (int m = 0; m < 4; ++m) {
                const int rr_ = row0 + ai * 128 + m * 16; float* xp = (rr_ < ML ? xl + (size_t)rr_ * DM : xc + (size_t)(rr_ - ML) * DM) + col0;
#pragma unroll
                for (int bj = 0; bj < 2; ++bj)
#pragma unroll
                    for (int n = 0; n < 2; ++n) { f32x4 x = *(f32x4*)(xp + bj * 128 + n * 16); x = x * ALPHA + gv[bj][n] * acc[ai][bj][m][n]; *(f32x4*)(xp + bj * 128 + n * 16) = x; }
            }
    }
};
struct EpiSplit {
    char* ws;
    DI void operator()(AccRef acc, const Unit& u, int wr, int wc, int fr, int fq) const {
        bf16_t* base; int ld, c0; const int pn = u.pn;
        if (pn < 2) { base = (bf16_t*)(ws + OFF_QB); ld = 512; c0 = pn * 256; }
        else if (pn == 2) { base = (bf16_t*)(ws + OFF_KVB); ld = 256; c0 = 0; }
        else if (pn < 9) { base = (bf16_t*)(ws + OFF_ZR); ld = 1536; c0 = (pn - 3) * 256; }
        else if (pn < 11) { base = (bf16_t*)(ws + OFF_ZS); ld = 512; c0 = (pn - 9) * 256; }
        else { base = (bf16_t*)(ws + OFF_LIN); ld = 512; c0 = (pn - 11) * 256; }
        const int row0 = u.pm * 256 + wr * 64 + fr, col0 = c0 + wc * 32 + 8 * fq;
#pragma unroll
        for (int ai = 0; ai < 2; ++ai)
#pragma unroll
            for (int m = 0; m < 4; ++m)
#pragma unroll
                for (int bj = 0; bj < 2; ++bj) store8(base + (size_t)(row0 + ai * 128 + m * 16) * ld + col0 + bj * 128, acc[ai][bj][m][0], acc[ai][bj][m][1]);
    }
};
struct EpiLora {
    char* ws; const float* w0; const float* a0;
    DI void operator()(AccRef acc, const Unit& u, int wr, int wc, int fr, int fq) const {
        const int kind = u.pn >> 1;
        bf16_t* base = (bf16_t*)(ws + (kind == 0 ? OFF_DWF : kind == 1 ? OFF_DWB : kind == 2 ? OFF_DWA : OFF_G));
        const float* bias = kind < 2 ? w0 + kind * 512 : a0;
        const int row0 = u.pm * 256 + wr * 64 + fr, col0 = (u.pn & 1) * 256 + wc * 32 + 8 * fq;
#pragma unroll
        for (int bj = 0; bj < 2; ++bj) {
            f32x4 b0 = (f32x4){0.f, 0.f, 0.f, 0.f}, b1 = b0;
            if (kind < 3) { b0 = *(const f32x4*)(bias + col0 + bj * 128); b1 = *(const f32x4*)(bias + col0 + bj * 128 + 4); }
#pragma unroll
            for (int ai = 0; ai < 2; ++ai)
#pragma unroll
                for (int m = 0; m < 4; ++m) {
                    f32x4 v0 = acc[ai][bj][m][0] + b0, v1 = acc[ai][bj][m][1] + b1;
                    if (kind < 2) {
#pragma unroll
                        for (int j = 0; j < 4; ++j) { v0[j] = __expf(-0.606531f * sigm(v0[j])); v1[j] = __expf(-0.606531f * sigm(v1[j])); }
                    } else if (kind == 2) {
#pragma unroll
                        for (int j = 0; j < 4; ++j) { v0[j] = sigm(v0[j]); v1[j] = sigm(v1[j]); }
                    }
                    store8(base + (size_t)(row0 + ai * 128 + m * 16) * 512 + col0 + bj * 128, v0, v1);
                }
        }
    }
};
struct EpiGlu {
    const bf16_t* yg; bf16_t* ys; const float* bias;
    DI void operator()(AccRef acc, const Unit& u, int wr, int wc, int fr, int fq) const {
        const int row0 = u.pm * 256 + wr * 64 + fr, col0 = u.pn * 256 + wc * 32 + 8 * fq;
#pragma unroll
        for (int bj = 0; bj < 2; ++bj) {
            const f32x4 b0 = *(const f32x4*)(bias + col0 + bj * 128), b1 = *(const f32x4*)(bias + col0 + bj * 128 + 4);
#pragma unroll
            for (int ai = 0; ai < 2; ++ai)
#pragma unroll
                for (int m = 0; m < 4; ++m) {
                    const size_t o = (size_t)(row0 + ai * 128 + m * 16) * 512 + col0 + bj * 128;
                    const u32x4 y = *(const u32x4*)(yg + o);
                    f32x4 v0 = acc[ai][bj][m][0] + b0, v1 = acc[ai][bj][m][1] + b1;
                    v0[0] = bflo(y.x) * sigm(v0[0]); v0[1] = bfhi(y.x) * sigm(v0[1]); v0[2] = bflo(y.y) * sigm(v0[2]); v0[3] = bfhi(y.y) * sigm(v0[3]);
                    v1[0] = bflo(y.z) * sigm(v1[0]); v1[1] = bfhi(y.z) * sigm(v1[1]); v1[2] = bflo(y.w) * sigm(v1[2]); v1[3] = bfhi(y.w) * sigm(v1[3]);
                    store8(ys + o, v0, v1);
                }
        }
    }
};
struct EpiGate {
    bf16_t* gb;
    DI void operator()(AccRef acc, const Unit& u, int wr, int wc, int fr, int fq) const {
        const int row0 = u.pm * 256 + wr * 64 + fr, col0 = u.pn * 256 + wc * 32 + 8 * fq;
#pragma unroll
        for (int ai = 0; ai < 2; ++ai)
#pragma unroll
            for (int m = 0; m < 4; ++m)
#pragma unroll
                for (int bj = 0; bj < 2; ++bj) { f32x4 a0 = acc[ai][bj][m][0], a1 = acc[ai][bj][m][1];
#pragma unroll
                    for (int j = 0; j < 4; ++j) { a0[j] = sigm(a0[j]); a1[j] = sigm(a1[j]); }
                    store8(gb + (size_t)(row0 + ai * 128 + m * 16) * 1024 + col0 + bj * 128, a0, a1); }
    }
};
struct EpiBranch {
    const bf16_t* gb; bf16_t* mg; int first;
    DI void operator()(AccRef acc, const Unit& u, int wr, int wc, int fr, int fq) const {
        const int row0 = u.pm * 256 + wr * 64 + fr, col0 = u.pn * 256 + wc * 32 + 8 * fq;
#pragma unroll
        for (int ai = 0; ai < 2; ++ai)
#pragma unroll
            for (int m = 0; m < 4; ++m)
#pragma unroll
                for (int bj = 0; bj < 2; ++bj) {
                    const size_t o = (size_t)(row0 + ai * 128 + m * 16) * 1024 + col0 + bj * 128;
                    f32x4 a0 = acc[ai][bj][m][0], a1 = acc[ai][bj][m][1];
                    const u32x4 g = *(const u32x4*)(gb + o);
                    a0[0] *= bflo(g.x); a0[1] *= bfhi(g.x); a0[2] *= bflo(g.y); a0[3] *= bfhi(g.y);
                    a1[0] *= bflo(g.z); a1[1] *= bfhi(g.z); a1[2] *= bflo(g.w); a1[3] *= bfhi(g.w);
                    if (!first) { const u32x4 q = *(const u32x4*)(mg + o);
                        a0[0] += bflo(q.x); a0[1] += bfhi(q.x); a0[2] += bflo(q.y); a0[3] += bfhi(q.y);
                        a1[0] += bflo(q.z); a1[1] += bfhi(q.z); a1[2] += bflo(q.w); a1[3] += bfhi(q.w); }
                    store8(mg + o, a0, a1);
                }
    }
};

__device__ __forceinline__ void phase_ada(const Ctx& cx, float* lds) {
    const int tid = cx.tid;
    for (int i = tid; i < 5 * 1024; i += 512) { const int r = i >> 10, k = i & 1023; const float v = r < 4 ? cx.p->in[I_C][r * 1024 + k] : cx.p->in[I_CCTX][k]; lds[i] = v * sigm(v); }
    __syncthreads();
    float* red = lds + 5120; float* mods = (float*)(cx.p->ws + OFF_MODS);
    for (int task = cx.bid; task < 288; task += cx.nb) {
        const int l = task / 144, n0 = (task % 144) * 64, kc = tid >> 6, col = tid & 63;
        const float* w = cx.p->in[I_WADA] + (size_t)l * 1024 * 9216 + n0 + col;
        float a0 = 0.f, a1 = 0.f, a2 = 0.f, a3 = 0.f, a4 = 0.f;
        for (int k = kc * 128; k < kc * 128 + 128; ++k) { const float wv = w[(size_t)k * 9216]; a0 += lds[k] * wv; a1 += lds[1024 + k] * wv; a2 += lds[2048 + k] * wv; a3 += lds[3072 + k] * wv; a4 += lds[4096 + k] * wv; }
        red[(kc * 5 + 0) * 64 + col] = a0; red[(kc * 5 + 1) * 64 + col] = a1; red[(kc * 5 + 2) * 64 + col] = a2; red[(kc * 5 + 3) * 64 + col] = a3; red[(kc * 5 + 4) * 64 + col] = a4;
        __syncthreads();
        if (tid < 320) { const int r = tid >> 6, c2 = tid & 63; float s = cx.p->in[I_BADA][l * 9216 + n0 + c2];
            for (int q = 0; q < 8; ++q) s += red[(q * 5 + r) * 64 + c2];
            mods[(size_t)(l * 5 + r) * 9216 + n0 + c2] = s; }
        __syncthreads();
    }
}

DI int map_w1(int n) { const int bj = n / 2816, q = n - bj * 2816; return (q >> 7) * 256 + bj * 128 + (q & 127); }
DI int map_win(int n) { return n < 2304 ? n : (n < 2624 ? 2816 + (n - 2304) : (n < 3136 ? 2304 + (n - 2624) : 3328 + (n - 3136))); }
__device__ __forceinline__ void phase_cv(const Ctx& cx, int layer, float* lds) {
    const int tid = cx.tid;
    char* wb = cx.p->ws + OFF_WB;
    const int T0 = 1408, T1 = T0 + 704, T2 = T1 + 1408, T3 = T2 + 704, T4 = T3 + 1552, T5 = T4 + 384, T6 = T5 + 256, T7 = T6 + 64;
    struct CvJob { const float* src; char* dst; int K, N, mode, k0, n0; };
    auto decode = [&](int task) -> CvJob {
        CvJob j; int t;
        if (task < T0) { t = task; j.src = cx.p->in[I_FWIN] + (size_t)(layer * 2 + 0) * 1024 * 5632; j.K = 1024; j.N = 5632; j.mode = 1; j.dst = wb + WB_W1A; }
        else if (task < T1) { t = task - T0; j.src = cx.p->in[I_FWOUT] + (size_t)(layer * 2 + 0) * 2816 * 1024; j.K = 2816; j.N = 1024; j.mode = 0; j.dst = wb + WB_W2A; }
        else if (task < T2) { t = task - T1; j.src = cx.p->in[I_FWIN] + (size_t)(layer * 2 + 1) * 1024 * 5632; j.K = 1024; j.N = 5632; j.mode = 1; j.dst = wb + WB_W1B; }
        else if (task < T3) { t = task - T2; j.src = cx.p->in[I_FWOUT] + (size_t)(layer * 2 + 1) * 2816 * 1024; j.K = 2816; j.N = 1024; j.mode = 0; j.dst = wb + WB_W2B; }
        else if (task < T4) { t = task - T3; j.src = cx.p->in[I_WIN] + (size_t)layer * 1024 * 6208; j.K = 1024; j.N = 6208; j.mode = 2; j.dst = wb + WB_WIN; }
        else if (task < T5) { t = task - T4; const int i = t / 128; t -= i * 128; j.src = cx.p->in[I_BP] + (size_t)(layer * 3 + i) * 512 * 1024; j.K = 512; j.N = 1024; j.mode = 0; j.dst = wb + WB_BP + (size_t)i * 1024 * 512 * 2; }
        else if (task < T6) { t = task - T5; j.src = cx.p->in[I_WOUT] + (size_t)layer * 1024 * 1024; j.K = 1024; j.N = 1024; j.mode = 0; j.dst = wb + WB_WOUT; }
        else { t = task - T6; j.src = cx.p->in[I_GLUW] + (size_t)layer * 512 * 512; j.K = 512; j.N = 512; j.mode = 0; j.dst = wb + WB_GLU; }
        const int nk = j.K / 64; j.k0 = (t % nk) * 64; j.n0 = (t / nk) * 64; return j;
    };
    const int lr_ = tid >> 4, lc4 = (tid & 15) * 4;
    int task = cx.bid; CvJob cur{}; f32x4 va = (f32x4){0.f, 0.f, 0.f, 0.f}, vb = va;
    if (task < T7) { cur = decode(task); va = *(const f32x4*)(cur.src + (size_t)(cur.k0 + lr_) * cur.N + cur.n0 + lc4); vb = *(const f32x4*)(cur.src + (size_t)(cur.k0 + lr_ + 32) * cur.N + cur.n0 + lc4); }
    for (; task < T7; task += cx.nb) {
        const bool hn = task + cx.nb < T7; CvJob nxt = cur; f32x4 na = va, nb2 = vb;
        if (hn) { nxt = decode(task + cx.nb); na = *(const f32x4*)(nxt.src + (size_t)(nxt.k0 + lr_) * nxt.N + nxt.n0 + lc4); nb2 = *(const f32x4*)(nxt.src + (size_t)(nxt.k0 + lr_ + 32) * nxt.N + nxt.n0 + lc4); }
        lds[lr_ * 65 + lc4] = va[0]; lds[lr_ * 65 + lc4 + 1] = va[1]; lds[lr_ * 65 + lc4 + 2] = va[2]; lds[lr_ * 65 + lc4 + 3] = va[3];
        lds[(lr_ + 32) * 65 + lc4] = vb[0]; lds[(lr_ + 32) * 65 + lc4 + 1] = vb[1]; lds[(lr_ + 32) * 65 + lc4 + 2] = vb[2]; lds[(lr_ + 32) * 65 + lc4 + 3] = vb[3];
        __syncthreads();
        {   const int n = tid >> 3, k8 = (tid & 7) * 8; float v[8];
#pragma unroll
            for (int j = 0; j < 8; ++j) v[j] = lds[(k8 + j) * 65 + n];
            const int ng = cur.n0 + n; const int dr = cur.mode == 1 ? map_w1(ng) : (cur.mode == 2 ? map_win(ng) : ng);
            u32x4 w; w.x = pk2(v[0], v[1]); w.y = pk2(v[2], v[3]); w.z = pk2(v[4], v[5]); w.w = pk2(v[6], v[7]);
            *(u32x4*)(cur.dst + ((size_t)dr * cur.K + cur.k0 + k8) * 2) = w; }
        __syncthreads();
        cur = nxt; va = na; vb = nb2;
    }
    const size_t gtid = (size_t)cx.bid * 512 + tid, gsz = (size_t)cx.nb * 512;
    {   u32x4 z = (u32x4){0u, 0u, 0u, 0u}; u32x4* d = (u32x4*)(wb + WB_WIN + (size_t)3136 * 1024 * 2);
        for (size_t i = gtid; i < (size_t)192 * 1024 * 2 / 16; i += gsz) d[i] = z; }
    {   bf16_t* d = (bf16_t*)(wb + WB_LORA);
        const float* w2 = cx.p->in[I_W2] + (size_t)layer * 2 * 64 * 512; const float* a2 = cx.p->in[I_A2] + (size_t)layer * 64 * 512; const float* g2 = cx.p->in[I_G2] + (size_t)layer * 128 * 512;
        for (size_t i = gtid; i < (size_t)2048 * 384; i += gsz) { const int n = (int)(i / 384), k = (int)(i % 384); const int kind = n >> 9, c = n & 511; float v = 0.f;
            if (kind == 0) { if (k < 64) v = w2[(size_t)k * 512 + c]; }
            else if (kind == 1) { if (k >= 64 && k < 128) v = w2[(size_t)(64 + k - 64) * 512 + c]; }
            else if (kind == 2) { if (k >= 128 && k < 192) v = a2[(size_t)(k - 128) * 512 + c]; }
            else { if (k >= 192 && k < 320) v = g2[(size_t)(k - 192) * 512 + c]; }
            d[i] = f2bf(v); } }
}

DI void row_stats2(f32x4 (&v)[2][4], float (&rstd)[2]) {
    float s[2], q[2];
#pragma unroll
    for (int k = 0; k < 2; ++k) { s[k] = 0.f;
#pragma unroll
        for (int i = 0; i < 4; ++i) s[k] += v[k][i][0] + v[k][i][1] + v[k][i][2] + v[k][i][3]; }
    s[0] += swz<1>(s[0]); s[1] += swz<1>(s[1]); s[0] += swz<2>(s[0]); s[1] += swz<2>(s[1]); s[0] += swz<4>(s[0]); s[1] += swz<4>(s[1]);
    s[0] += swz<8>(s[0]); s[1] += swz<8>(s[1]); s[0] += swz<16>(s[0]); s[1] += swz<16>(s[1]);
#pragma unroll
    for (int k = 0; k < 2; ++k) {
        const float mean = (__builtin_bit_cast(float, __builtin_amdgcn_readlane(__builtin_bit_cast(int, s[k]), 0)) + __builtin_bit_cast(float, __builtin_amdgcn_readlane(__builtin_bit_cast(int, s[k]), 32))) * (1.0f / 1024.0f);
        q[k] = 0.f;
#pragma unroll
        for (int i = 0; i < 4; ++i) { v[k][i] -= mean; q[k] += v[k][i][0] * v[k][i][0] + v[k][i][1] * v[k][i][1] + v[k][i][2] * v[k][i][2] + v[k][i][3] * v[k][i][3]; }
    }
    q[0] += swz<1>(q[0]); q[1] += swz<1>(q[1]); q[0] += swz<2>(q[0]); q[1] += swz<2>(q[1]); q[0] += swz<4>(q[0]); q[1] += swz<4>(q[1]);
    q[0] += swz<8>(q[0]); q[1] += swz<8>(q[1]); q[0] += swz<16>(q[0]); q[1] += swz<16>(q[1]);
#pragma unroll
    for (int k = 0; k < 2; ++k) {
        const float var = (__builtin_bit_cast(float, __builtin_amdgcn_readlane(__builtin_bit_cast(int, q[k]), 0)) + __builtin_bit_cast(float, __builtin_amdgcn_readlane(__builtin_bit_cast(int, q[k]), 32))) * (1.0f / 1024.0f);
        rstd[k] = rsqrtf(var + 1e-6f);
    }
}
template <int MODE>
__device__ __forceinline__ void phase_row(const Ctx& cx, int M, const float* lng, const float* lnb, const float* mod_base  , bf16_t* U,
                                          const float* gate_base = nullptr, float coef = 0.f, const bf16_t* H = nullptr) {
    const int lane = cx.tid & 63, gw = cx.bid * 8 + (cx.tid >> 6), nw = cx.nb * 8;
    f32x4 nv[2][4]; u32x2 nh[2][4];
    auto issue = [&](int pi) {
#pragma unroll
        for (int k = 0; k < 2; ++k) {
            const int r = 2 * pi + k;
            const float* src = (MODE & 1) ? (r < ML ? cx.p->in[I_X] + (size_t)r * DM : cx.p->in[I_CTX] + (size_t)(r - ML) * DM) : xrow(cx, r);
#pragma unroll
            for (int i = 0; i < 4; ++i) { nv[k][i] = *(const f32x4*)(src + i * 256 + lane * 4); if (MODE & 8) nh[k][i] = *(const u32x2*)(H + (size_t)r * DM + i * 256 + lane * 4); }
        }
    };
    const int npair = M >> 1;
    if (gw < npair) issue(gw);
    for (int pi = gw; pi < npair; pi += nw) {
        const int r0 = 2 * pi; const int mi = r0 < ML ? (r0 >> 13) : 4;
        f32x4 gv[4], lg[4], lb[4], sc4[4], sh4[4];
#pragma unroll
        for (int i = 0; i < 4; ++i) {
            if (MODE & 8) gv[i] = *(const f32x4*)(gate_base + (size_t)mi * 9216 + i * 256 + lane * 4);
            if (MODE & 2) { lg[i] = *(const f32x4*)(lng + i * 256 + lane * 4); lb[i] = *(const f32x4*)(lnb + i * 256 + lane * 4); }
            if (MODE & 4) { sh4[i] = *(const f32x4*)(mod_base + (size_t)mi * 9216 + i * 256 + lane * 4); sc4[i] = *(const f32x4*)(mod_base + (size_t)mi * 9216 + 1024 + i * 256 + lane * 4); }
        }
        f32x4 v[2][4]; float* xp[2];
#pragma unroll
        for (int k = 0; k < 2; ++k) { xp[k] = xrow(cx, r0 + k);
#pragma unroll
            for (int i = 0; i < 4; ++i) {
                if (MODE & 8) { const u32x2 hw = nh[k][i]; v[k][i] = nv[k][i] * ALPHA + (gv[i] * coef) * (f32x4){bflo(hw.x), bfhi(hw.x), bflo(hw.y), bfhi(hw.y)}; }
                else v[k][i] = nv[k][i];
            } }
        __builtin_amdgcn_sched_barrier(0);
        issue((pi + nw < npair) ? pi + nw : pi);
        __builtin_amdgcn_sched_barrier(0);
        if ((MODE & 1) && !(MODE & 16) && !(MODE & 2)) {
#pragma unroll
            for (int k = 0; k < 2; ++k)
#pragma unroll
                for (int i = 0; i < 4; ++i) *(f32x4*)(xp[k] + i * 256 + lane * 4) = v[k][i];
        }
        if (MODE & 2) {
            float rstd[2]; row_stats2(v, rstd);
#pragma unroll
            for (int i = 0; i < 4; ++i)
#pragma unroll
                for (int k = 0; k < 2; ++k) { v[k][i] = v[k][i] * rstd[k] * lg[i] + lb[i]; *(f32x4*)(xp[k] + i * 256 + lane * 4) = v[k][i]; }
        }
        if (MODE & 4) {
            float rstd[2]; row_stats2(v, rstd);
#pragma unroll
            for (int k = 0; k < 2; ++k)
#pragma unroll
                for (int i = 0; i < 4; ++i) { const f32x4 y = v[k][i] * rstd[k] * (sc4[i] + 1.0f) + sh4[i]; u32x2 w; w.x = pk2(y[0], y[1]); w.y = pk2(y[2], y[3]); *(u32x2*)(U + (size_t)(r0 + k) * DM + i * 256 + lane * 4) = w; }
        }
    }
}

__device__ __forceinline__ void phase_ap(const Ctx& cx, int layer) {
    const int lane = cx.tid & 63, gw = cx.bid * 8 + (cx.tid >> 6), nw = cx.nb * 8;
    bf16_t* Q = (bf16_t*)(cx.p->ws + OFF_QB); const bf16_t* KV = (const bf16_t*)(cx.p->ws + OFF_KVB);
    bf16_t* Kr = (bf16_t*)(cx.p->ws + OFF_KR); bf16_t* Vt = (bf16_t*)(cx.p->ws + OFF_VT);
    const bf16_t* ZR = (const bf16_t*)(cx.p->ws + OFF_ZR); const bf16_t* LIN = (const bf16_t*)(cx.p->ws + OFF_LIN);
    bf16_t* ZF = (bf16_t*)(cx.p->ws + OFF_ZF); bf16_t* AP = (bf16_t*)(cx.p->ws + OFF_AP);
    const float* mu = cx.p->in[I_MU] + (size_t)layer * 1856;
    const float QS = 0.125f * LOG2E;
    for (int r = gw; r < MT; r += nw) {
        const bool lat = r < ML; int b, pos, prow = 0, pcol = 0, first, lastt;
        if (lat) { b = r >> 13; const int t = r & 8191; pos = 256 + t; prow = t >> 6; pcol = t & 63; first = (t == 0); lastt = (t == 8191); }
        else { const int q = r - ML; b = q >> 8; pos = q & 255; first = (pos == 0); lastt = (pos == 255); }
#pragma unroll
        for (int i = 0; i < 4; ++i) {
            const int pg = lane + 64 * i, hd = pg >> 5, pi = pg & 31, half = pi >> 4, i16 = pi & 15; const int i1 = hd * 64 + half * 32 + i16;
            const float x1 = bf2f(Q[(size_t)r * 512 + i1]), x2 = bf2f(Q[(size_t)r * 512 + i1 + 16]);
            float c = 1.f, s = 0.f;
            if (lat) { const float ang = (float)(half ? pcol : prow) * exp2f(-(float)i16 * (13.287712379549449f / 16.0f)); c = __cosf(ang); s = __sinf(ang); }
            Q[(size_t)r * 512 + i1] = f2bf((x1 * c - x2 * s) * QS); Q[(size_t)r * 512 + i1 + 16] = f2bf((x2 * c + x1 * s) * QS);
        }
        {
            const int hd = lane >> 5, pi = lane & 31, half = pi >> 4, i16 = pi & 15; const int i1 = hd * 64 + half * 32 + i16;
            const float x1 = bf2f(KV[(size_t)r * 256 + i1]), x2 = bf2f(KV[(size_t)r * 256 + i1 + 16]);
            float c = 1.f, s = 0.f;
            if (lat) { const float ang = (float)(half ? pcol : prow) * exp2f(-(float)i16 * (13.287712379549449f / 16.0f)); c = __cosf(ang); s = __sinf(ang); }
            bf16_t* kd = Kr + ((size_t)(b * 2 + hd) * 8448 + pos) * 64 + half * 32 + i16;
            kd[0] = f2bf(x1 * c - x2 * s); kd[16] = f2bf(x2 * c + x1 * s);
        }
#pragma unroll
        for (int i = 0; i < 2; ++i) { const int idx = lane + 64 * i, hk = idx >> 6, d = idx & 63; Vt[((size_t)(b * 2 + hk) * 64 + d) * 8448 + pos] = KV[(size_t)r * 256 + 128 + idx]; }
#pragma unroll
        for (int i = 0; i < 3; ++i) {
            const int c0 = i * 512 + lane * 8; const u32x4 zc = *(const u32x4*)(ZR + (size_t)r * 1536 + c0);
            u32x4 zp = (u32x4){0u, 0u, 0u, 0u}, zn = zp;
            if (!first) zp = *(const u32x4*)(ZR + (size_t)(r - 1) * 1536 + c0);
            if (!lastt) zn = *(const u32x4*)(ZR + (size_t)(r + 1) * 1536 + c0);
            const f32x4 m0 = *(const f32x4*)(mu + c0), m1 = *(const f32x4*)(mu + c0 + 4);
            float o[8]; const unsigned cw[4] = {zc.x, zc.y, zc.z, zc.w}, pw[4] = {zp.x, zp.y, zp.z, zp.w}, nwv[4] = {zn.x, zn.y, zn.z, zn.w};
#pragma unroll
            for (int j = 0; j < 4; ++j) { const float ma = j < 2 ? m0[2 * j] : m1[2 * j - 4], mb = j < 2 ? m0[2 * j + 1] : m1[2 * j - 3];
                const float za = bflo(cw[j]), zb = bfhi(cw[j]);
                o[2 * j] = za + ma * (0.5f * (bflo(pw[j]) + bflo(nwv[j])) - za); o[2 * j + 1] = zb + mb * (0.5f * (bfhi(pw[j]) + bfhi(nwv[j])) - zb); }
            u32x4 w; w.x = pk2(o[0], o[1]); w.y = pk2(o[2], o[3]); w.z = pk2(o[4], o[5]); w.w = pk2(o[6], o[7]);
            *(u32x4*)(ZF + (size_t)r * 1536 + c0) = w;
        }
        if (lane < 48) {
            const int c0 = lane * 8; u32x4 w = (u32x4){0u, 0u, 0u, 0u};
            if (lane < 40) {
                const u32x4 zc = *(const u32x4*)(LIN + (size_t)r * 512 + c0); u32x4 zp = (u32x4){0u, 0u, 0u, 0u}, zn = zp;
                if (!first) zp = *(const u32x4*)(LIN + (size_t)(r - 1) * 512 + c0);
                if (!lastt) zn = *(const u32x4*)(LIN + (size_t)(r + 1) * 512 + c0);
                const f32x4 m0 = *(const f32x4*)(mu + 1536 + c0), m1 = *(const f32x4*)(mu + 1536 + c0 + 4);
                float o[8]; const unsigned cw[4] = {zc.x, zc.y, zc.z, zc.w}, pw[4] = {zp.x, zp.y, zp.z, zp.w}, nwv[4] = {zn.x, zn.y, zn.z, zn.w};
#pragma unroll
                for (int j = 0; j < 4; ++j) { const float ma = j < 2 ? m0[2 * j] : m1[2 * j - 4], mb = j < 2 ? m0[2 * j + 1] : m1[2 * j - 3];
                    const float za = bflo(cw[j]), zb = bfhi(cw[j]);
                    o[2 * j] = za + ma * (0.5f * (bflo(pw[j]) + bflo(nwv[j])) - za); o[2 * j + 1] = zb + mb * (0.5f * (bfhi(pw[j]) + bfhi(nwv[j])) - zb); }
                if (c0 < 128) {
#pragma unroll
                    for (int j = 0; j < 8; ++j) o[j] = 1.0f - 2.0f * __builtin_amdgcn_rcpf(1.0f + __expf(2.0f * o[j]));
                } else if (c0 >= 192) {
#pragma unroll
                    for (int j = 0; j < 8; ++j) o[j] = sigm(o[j]);
                }
                w.x = pk2(o[0], o[1]); w.y = pk2(o[2], o[3]); w.z = pk2(o[4], o[5]); w.w = pk2(o[6], o[7]);
            }
            *(u32x4*)(AP + (size_t)r * 384 + c0) = w;
        }
    }
}

__device__ __forceinline__ void phase_attn(const Ctx& cx, int layer, bf16_t* Out) {
    const int lane = cx.tid & 63, gw = cx.bid * 8 + (cx.tid >> 6), nw = cx.nb * 8, fr = lane & 15, fq = lane >> 4;
    const bf16_t* Q = (const bf16_t*)(cx.p->ws + OFF_QB); const bf16_t* Kr = (const bf16_t*)(cx.p->ws + OFF_KR); const bf16_t* Vt = (const bf16_t*)(cx.p->ws + OFF_VT);
    const int ntask = layer == 1 ? 4096 : 4224;
    for (int task = gw; task < ntask; task += nw) {
        const bool isctx = task >= 4096; const int tt = isctx ? task - 4096 : task; const int hk = tt & 1, qt = tt >> 1;
        int b, q0, rowbase;
        if (!isctx) { b = qt >> 9; q0 = (qt & 511) * 16; rowbase = b * 8192 + q0; } else { b = qt >> 4; q0 = (qt & 15) * 16; rowbase = ML + b * 256 + q0; }
        const bf16_t* Kb = Kr + (size_t)(b * 2 + hk) * 8448 * 64; const bf16_t* Vb = Vt + (size_t)(b * 2 + hk) * 64 * 8448;
        bf16x8 qf[4][2]; float mrun[4], lsum[4]; f32x4 o[4][4];
#pragma unroll
        for (int g = 0; g < 4; ++g) {
#pragma unroll
            for (int ks = 0; ks < 2; ++ks) qf[g][ks] = *(const bf16x8*)(Q + (size_t)(rowbase + fr) * 512 + (hk * 4 + g) * 64 + ks * 32 + fq * 8);
            mrun[g] = cx.p->in[I_SINK][layer * 8 + hk * 4 + g] * LOG2E; lsum[g] = (fq == 0) ? 1.0f : 0.0f;
#pragma unroll
            for (int mt = 0; mt < 4; ++mt) o[g][mt] = (f32x4){0.f, 0.f, 0.f, 0.f};
        }
        int kt_lo = 0, n2 = 0;
        if (!isctx) { kt_lo = q0 - 128; if (kt_lo < 0) kt_lo = 0; kt_lo &= ~31; int kt_hi = q0 + 16 + 128; if (kt_hi > 8192) kt_hi = 8192; kt_hi = (kt_hi + 31) & ~31; n2 = (kt_hi - kt_lo) >> 5; }
        const int tq = q0 + fr, ntile = 8 + n2;
        bf16x8 kf[2][2]; u32x2 vf[4][2];
        {   const int pos0 = 0;
#pragma unroll
            for (int ks = 0; ks < 2; ++ks) { kf[0][ks] = *(const bf16x8*)(Kb + (size_t)(pos0 + fr) * 64 + ks * 32 + fq * 8); kf[1][ks] = *(const bf16x8*)(Kb + (size_t)(pos0 + 16 + fr) * 64 + ks * 32 + fq * 8); }
#pragma unroll
            for (int mt = 0; mt < 4; ++mt) { const bf16_t* vp = Vb + (size_t)(mt * 16 + fr) * 8448 + pos0 + fq * 4; vf[mt][0] = *(const u32x2*)vp; vf[mt][1] = *(const u32x2*)(vp + 16); } }
        for (int it = 0; it < ntile; ++it) {
            const bool loc = it >= 8; const int kt = loc ? kt_lo + (it - 8) * 32 : 0;
            bf16x8 kn[2][2]; u32x2 vn[4][2];
            {   const int itn = (it + 1 < ntile) ? it + 1 : it; const int pos0 = itn >= 8 ? 256 + kt_lo + (itn - 8) * 32 : itn * 32;
#pragma unroll
                for (int ks = 0; ks < 2; ++ks) { kn[0][ks] = *(const bf16x8*)(Kb + (size_t)(pos0 + fr) * 64 + ks * 32 + fq * 8); kn[1][ks] = *(const bf16x8*)(Kb + (size_t)(pos0 + 16 + fr) * 64 + ks * 32 + fq * 8); }
#pragma unroll
                for (int mt = 0; mt < 4; ++mt) { const bf16_t* vp = Vb + (size_t)(mt * 16 + fr) * 8448 + pos0 + fq * 4; vn[mt][0] = *(const u32x2*)vp; vn[mt][1] = *(const u32x2*)(vp + 16); } }
            bool msk0[4], msk1[4];
#pragma unroll
            for (int j = 0; j < 4; ++j) { const int d0 = kt + fq * 4 + j - tq, d1 = d0 + 16; msk0[j] = loc && (d0 > 128 || d0 < -128); msk1[j] = loc && (d1 > 128 || d1 < -128); }
            f32x4 s0[4], s1[4]; float mx[4], al[4];
#pragma unroll
            for (int g = 0; g < 4; ++g) {
                s0[g] = (f32x4){0.f, 0.f, 0.f, 0.f}; s1[g] = s0[g];
#pragma unroll
                for (int ks = 0; ks < 2; ++ks) { s0[g] = __builtin_amdgcn_mfma_f32_16x16x32_bf16(kf[0][ks], qf[g][ks], s0[g], 0, 0, 0); s1[g] = __builtin_amdgcn_mfma_f32_16x16x32_bf16(kf[1][ks], qf[g][ks], s1[g], 0, 0, 0); }
            }
#pragma unroll
            for (int g = 0; g < 4; ++g) {
#pragma unroll
                for (int j = 0; j < 4; ++j) { if (msk0[j]) s0[g][j] = -1e30f; if (msk1[j]) s1[g][j] = -1e30f; }
                mx[g] = fmaxf(fmaxf(fmaxf(s0[g][0], s0[g][1]), fmaxf(s0[g][2], s0[g][3])), fmaxf(fmaxf(s1[g][0], s1[g][1]), fmaxf(s1[g][2], s1[g][3])));
            }
#pragma unroll
            for (int g = 0; g < 4; ++g) mx[g] = fmaxf(mx[g], swz<16>(mx[g]));
#pragma unroll
            for (int g = 0; g < 4; ++g) mx[g] = fmaxf(mx[g], xor32(lane, mx[g]));
            bf16x8 pf[4];
#pragma unroll
            for (int g = 0; g < 4; ++g) {
                const float mn = fmaxf(mrun[g], mx[g]); al[g] = __builtin_amdgcn_exp2f(mrun[g] - mn); mrun[g] = mn;
                float ps = 0.f;
#pragma unroll
                for (int j = 0; j < 4; ++j) { s0[g][j] = __builtin_amdgcn_exp2f(s0[g][j] - mn); s1[g][j] = __builtin_amdgcn_exp2f(s1[g][j] - mn); ps += s0[g][j] + s1[g][j]; }
                lsum[g] = lsum[g] * al[g] + ps;
                u32x4 pw; pw.x = pk2(s0[g][0], s0[g][1]); pw.y = pk2(s0[g][2], s0[g][3]); pw.z = pk2(s1[g][0], s1[g][1]); pw.w = pk2(s1[g][2], s1[g][3]);
                pf[g] = __builtin_bit_cast(bf16x8, pw);
            }
#pragma unroll
            for (int mt = 0; mt < 4; ++mt) {
                u32x4 vw; vw.x = vf[mt][0].x; vw.y = vf[mt][0].y; vw.z = vf[mt][1].x; vw.w = vf[mt][1].y;
                const bf16x8 vfrag = __builtin_bit_cast(bf16x8, vw);
#pragma unroll
                for (int g = 0; g < 4; ++g) { o[g][mt] = o[g][mt] * al[g]; o[g][mt] = __builtin_amdgcn_mfma_f32_16x16x32_bf16(vfrag, pf[g], o[g][mt], 0, 0, 0); }
            }
#pragma unroll
            for (int ks = 0; ks < 2; ++ks) { kf[0][ks] = kn[0][ks]; kf[1][ks] = kn[1][ks]; }
#pragma unroll
            for (int mt = 0; mt < 4; ++mt) { vf[mt][0] = vn[mt][0]; vf[mt][1] = vn[mt][1]; }
        }
#pragma unroll
        for (int g = 0; g < 4; ++g) {
            float ls = lsum[g]; ls += swz<16>(ls); ls += xor32(lane, ls);
            const float inv = 1.0f / ls;
#pragma unroll
            for (int mt = 0; mt < 4; ++mt) { u32x2 w; w.x = pk2(o[g][mt][0] * inv, o[g][mt][1] * inv); w.y = pk2(o[g][mt][2] * inv, o[g][mt][3] * inv);
                *(u32x2*)(Out + (size_t)(rowbase + fr) * 512 + (hk * 4 + g) * 64 + mt * 16 + fq * 4) = w; }
        }
    }
}

__device__ __forceinline__ void phase_s5(const Ctx& cx, int layer, LAS unsigned char* lds) {
    const int tid = cx.tid, lane = tid & 63, wid = tid >> 6, fr = lane & 15, fq = lane >> 4;
    const bf16_t* ZS = (const bf16_t*)(cx.p->ws + OFF_ZS);
    LAS bf16_t* bbar = (LAS bf16_t*)lds;
    LAS float* Db = (LAS float*)(lds + 4096 + wid * 12800);
    LAS bf16_t* Xb = (LAS bf16_t*)(lds + 4096 + wid * 12800 + 8448);
    LAS float* Ex = (LAS float*)(lds + 4096 + 8 * 12800);
    for (int task = cx.bid; task < 256; task += cx.nb) {
        const int dir = task & 1, g = (task >> 1) & 31, b = task >> 6;
        const int pidx = ((layer * 2 + dir) * 32 + g) * 64 + lane;
        const float are = cx.p->in[I_SARE][pidx], aim = cx.p->in[I_SAIM][pidx], dt = __expf(cx.p->in[I_SLOG][(layer * 2 + dir) * 32 + g]);
        const float mag = __expf(are * dt), lr = mag * __cosf(aim * dt), li = mag * __sinf(aim * dt);
        __syncthreads();
        if (wid == 0) {
            const float den = are * are + aim * aim, cr = ((lr - 1.0f) * are + li * aim) / den, ci = (li * are - (lr - 1.0f) * aim) / den;
            const float* br = cx.p->in[I_SBRE] + ((size_t)(layer * 32 + g) * 64 + lane) * 16; const float* bi = cx.p->in[I_SBIM] + ((size_t)(layer * 32 + g) * 64 + lane) * 16;
#pragma unroll
            for (int c = 0; c < 16; ++c) { const float x = br[c], y = bi[c]; bbar[lane * 16 + c] = f2bf(cr * x - ci * y); bbar[(64 + lane) * 16 + c] = f2bf(cr * y + ci * x); }
        }
        __syncthreads();
        bf16x8 bfr[8];
#pragma unroll
        for (int t = 0; t < 8; ++t) { bfr[t] = (bf16x8){0, 0, 0, 0, 0, 0, 0, 0}; if (fq < 2) bfr[t] = *(const LAS bf16x8*)(bbar + (t * 16 + fr) * 16 + fq * 8); }
        bf16x8 cfr[4];
        {   const float* cre = cx.p->in[I_SCRE] + ((size_t)(layer * 32 + g) * 16 + fr) * 64; const float* cim = cx.p->in[I_SCIM] + ((size_t)(layer * 32 + g) * 16 + fr) * 64;
#pragma unroll
            for (int ks = 0; ks < 4; ++ks) { const int k0 = ks * 32 + fq * 8; u32x4 w;
                if (k0 < 64) { const f32x4 a = *(const f32x4*)(cre + k0), c = *(const f32x4*)(cre + k0 + 4); w.x = pk2(a[0], a[1]); w.y = pk2(a[2], a[3]); w.z = pk2(c[0], c[1]); w.w = pk2(c[2], c[3]); }
                else { const f32x4 a = *(const f32x4*)(cim + k0 - 64), c = *(const f32x4*)(cim + k0 - 60); w.x = pk2(-a[0], -a[1]); w.y = pk2(-a[2], -a[3]); w.z = pk2(-c[0], -c[1]); w.w = pk2(-c[2], -c[3]); }
                cfr[ks] = __builtin_bit_cast(bf16x8, w); } }
        float pr = lr, pi = li;
#pragma unroll
        for (int i = 0; i < 5; ++i) { const float a = pr * pr - pi * pi, c = 2.0f * pr * pi; pr = a; pi = c; }
        const float p32r = pr, p32i = pi;
#pragma unroll
        for (int i = 0; i < 5; ++i) { const float a = pr * pr - pi * pi, c = 2.0f * pr * pi; pr = a; pi = c; }
        { const float a = pr * p32r - pi * p32i, c = pr * p32i + pi * p32r; pr = a; pi = c; }
        bf16_t* Y = (bf16_t*)(cx.p->ws + (dir ? OFF_YB : OFF_YF));
        float hr = 0.f, hi = 0.f;
        for (int pass = 0; pass < 2; ++pass) {
            bf16x8 ufn = (bf16x8){0, 0, 0, 0, 0, 0, 0, 0};
            if (fq < 2) ufn = *(const bf16x8*)(ZS + (size_t)tokrow(b, dir, wid * 1056 + fr) * 512 + g * 16 + fq * 8);
            for (int grp = 0; grp < 66; ++grp) {
                const int p0 = wid * 1056 + grp * 16;
                const bf16x8 uf = ufn;
                if (fq < 2 && grp < 65) ufn = *(const bf16x8*)(ZS + (size_t)tokrow(b, dir, p0 + 16 + fr) * 512 + g * 16 + fq * 8);
#pragma unroll
                for (int t = 0; t < 8; ++t) {
                    const f32x4 d = __builtin_amdgcn_mfma_f32_16x16x32_bf16(uf, bfr[t], (f32x4){0.f, 0.f, 0.f, 0.f}, 0, 0, 0);
#pragma unroll
                    for (int j = 0; j < 4; ++j) Db[(fq * 4 + j) * 132 + t * 16 + fr] = d[j];
                }
                wave_lds_sync();
#pragma unroll
                for (int tk = 0; tk < 16; ++tk) {
                    const float dr = Db[tk * 132 + lane], di = Db[tk * 132 + 64 + lane];
                    const float nr = lr * hr - li * hi + dr, ni = lr * hi + li * hr + di; hr = nr; hi = ni;
                    if (pass) { Xb[tk * 136 + lane] = f2bf(hr); Xb[tk * 136 + 64 + lane] = f2bf(hi); }
                }
                wave_lds_sync();
                if (pass) {
                    f32x4 y = (f32x4){0.f, 0.f, 0.f, 0.f};
#pragma unroll
                    for (int ks = 0; ks < 4; ++ks) { const bf16x8 xf = *(const LAS bf16x8*)(Xb + fr * 136 + ks * 32 + fq * 8); y = __builtin_amdgcn_mfma_f32_16x16x32_bf16(xf, cfr[ks], y, 0, 0, 0); }
#pragma unroll
                    for (int j = 0; j < 4; ++j) Y[(size_t)tokrow(b, dir, p0 + fq * 4 + j) * 512 + g * 16 + fr] = f2bf(y[j]);
                    wave_lds_sync();
                }
            }
            if (pass == 0) {
                Ex[wid * 128 + lane] = hr; Ex[wid * 128 + 64 + lane] = hi;
                __syncthreads();
                hr = 0.f; hi = 0.f;
                for (int v = 0; v < wid; ++v) { const float er = Ex[v * 128 + lane], ei = Ex[v * 128 + 64 + lane]; const float nr = pr * hr - pi * hi + er, ni = pr * hi + pi * hr + ei; hr = nr; hi = ni; }
            }
        }
    }
}
__device__ __forceinline__ void phase_s5gelu(const Ctx& cx, int layer) {
    const size_t gtid = (size_t)cx.bid * 512 + cx.tid, gsz = (size_t)cx.nb * 512;
    bf16_t* ZS = (bf16_t*)(cx.p->ws + OFF_ZS); const bf16_t* YF = (const bf16_t*)(cx.p->ws + OFF_YF); const bf16_t* YB = (const bf16_t*)(cx.p->ws + OFF_YB);
    const float* dd = cx.p->in[I_SD] + layer * 512;
    for (size_t i = gtid; i < (size_t)MT * 64; i += gsz) {
        const int c0 = (int)(i & 63) * 8; const size_t o = i * 8;
        const u32x4 u = *(const u32x4*)(ZS + o), a = *(const u32x4*)(YF + o), b = *(const u32x4*)(YB + o);
        const unsigned uw[4] = {u.x, u.y, u.z, u.w}, aw[4] = {a.x, a.y, a.z, a.w}, bw[4] = {b.x, b.y, b.z, b.w}; float v[8];
#pragma unroll
        for (int j = 0; j < 4; ++j) { v[2 * j] = bflo(aw[j]) + bflo(bw[j]) + dd[c0 + 2 * j] * bflo(uw[j]); v[2 * j + 1] = bfhi(aw[j]) + bfhi(bw[j]) + dd[c0 + 2 * j + 1] * bfhi(uw[j]); }
#pragma unroll
        for (int j = 0; j < 8; ++j) { const float y = v[j], z = 0.7978845608028654f * (y + 0.044715f * y * y * y); const float th = 1.0f - 2.0f * __builtin_amdgcn_rcpf(1.0f + __expf(2.0f * z)); v[j] = 0.5f * y * (1.0f + th); }
        u32x4 w; w.x = pk2(v[0], v[1]); w.y = pk2(v[2], v[3]); w.z = pk2(v[4], v[5]); w.w = pk2(v[6], v[7]);
        *(u32x4*)(ZS + o) = w;
    }
}

DI float quad_allsum(float x) {
    x += __builtin_bit_cast(float, __builtin_amdgcn_mov_dpp(__builtin_bit_cast(int, x), 0xB1, 0xF, 0xF, true));
    x += __builtin_bit_cast(float, __builtin_amdgcn_mov_dpp(__builtin_bit_cast(int, x), 0x4E, 0xF, 0xF, true));
    return x;
}
template <int NR, bool HASV, bool HASO>
DI void rwkv_step(f32x2 (&S)[NR][8], const LAS float* sb, int cg, int voff, float (&o)[NR]) {
    float sa[NR];
    {   f32x2 ac[NR];
#pragma unroll
        for (int ii = 0; ii < NR; ++ii) ac[ii] = (f32x2){0.f, 0.f};
#pragma unroll
        for (int q = 0; q < 4; ++q) { const f32x4 k4 = *(const LAS f32x4*)(sb + 64 + 16 * cg + 4 * q); const f32x2 k0 = (f32x2){k4[0], k4[1]}, k1 = (f32x2){k4[2], k4[3]};
#pragma unroll
            for (int ii = 0; ii < NR; ++ii) { ac[ii] += S[ii][2 * q] * k0; ac[ii] += S[ii][2 * q + 1] * k1; } }
#pragma unroll
        for (int ii = 0; ii < NR; ++ii) sa[ii] = quad_allsum(ac[ii][0] + ac[ii][1]);
    }
    float vv[NR];
#pragma unroll
    for (int ii = 0; ii < NR; ++ii) vv[ii] = 0.f;
    if (HASV) {
        if (NR == 4) { const f32x4 v4 = *(const LAS f32x4*)(sb + 320 + voff); vv[0] = v4[0]; vv[1] = v4[1]; vv[NR - 2] = v4[2]; vv[NR - 1] = v4[3]; }
        else { const f32x2 v2 = *(const LAS f32x2*)(sb + 320 + voff); vv[0] = v2[0]; vv[1] = v2[1]; }
    }
    f32x2 oc[NR];
#pragma unroll
    for (int ii = 0; ii < NR; ++ii) oc[ii] = (f32x2){0.f, 0.f};
#pragma unroll
    for (int q = 0; q < 4; ++q) {
        const f32x4 w4 = *(const LAS f32x4*)(sb + 16 * cg + 4 * q), b4 = *(const LAS f32x4*)(sb + 128 + 16 * cg + 4 * q);
        const f32x2 w0 = (f32x2){w4[0], w4[1]}, w1 = (f32x2){w4[2], w4[3]}, b0 = (f32x2){b4[0], b4[1]}, b1 = (f32x2){b4[2], b4[3]};
        f32x2 k0 = (f32x2){0.f, 0.f}, k1 = k0, r0 = k0, r1 = k0;
        if (HASV) { const f32x4 k4 = *(const LAS f32x4*)(sb + 192 + 16 * cg + 4 * q); k0 = (f32x2){k4[0], k4[1]}; k1 = (f32x2){k4[2], k4[3]}; }
        if (HASO) { const f32x4 r4 = *(const LAS f32x4*)(sb + 256 + 16 * cg + 4 * q); r0 = (f32x2){r4[0], r4[1]}; r1 = (f32x2){r4[2], r4[3]}; }
#pragma unroll
        for (int ii = 0; ii < NR; ++ii) {
            const f32x2 nsa2 = (f32x2){-sa[ii], -sa[ii]};
            if (HASV) { const f32x2 v2 = (f32x2){vv[ii], vv[ii]}; S[ii][2 * q] = S[ii][2 * q] * w0 + (nsa2 * b0 + v2 * k0); S[ii][2 * q + 1] = S[ii][2 * q + 1] * w1 + (nsa2 * b1 + v2 * k1); }
            else { S[ii][2 * q] = S[ii][2 * q] * w0 + nsa2 * b0; S[ii][2 * q + 1] = S[ii][2 * q + 1] * w1 + nsa2 * b1; }
            if (HASO) { oc[ii] += S[ii][2 * q] * r0; oc[ii] += S[ii][2 * q + 1] * r1; }
        }
    }
#pragma unroll
    for (int ii = 0; ii < NR; ++ii) o[ii] = HASO ? quad_allsum(oc[ii][0] + oc[ii][1]) : 0.f;
}
template <bool PB>
__device__ __forceinline__ void phase_rwkv_scan(const Ctx& cx, int layer, LAS unsigned char* lds) {
    constexpr int NR = PB ? 2 : 4;
    const int tid = cx.tid, lane = tid & 63, wid = __builtin_amdgcn_readfirstlane(tid >> 6), pair = wid & 3, sub = wid >> 2;
    const int rg = lane >> 2, cg = lane & 3;
    const int rowbase = PB ? 32 * sub + 2 * rg : 4 * rg;
    LAS float* stg = (LAS float*)(lds + pair * 24576);
    const bf16_t* ZF = (const bf16_t*)(cx.p->ws + OFF_ZF); const bf16_t* DA = (const bf16_t*)(cx.p->ws + OFF_DWA);
    float* STT = (float*)(cx.p->ws + OFF_ST);
    const int NCH = PB ? 16 : 15, NT = 64 * NCH;
    for (int task = cx.bid * 4 + pair; task < NT; task += cx.nb * 4) {
        const int chain = task / NCH, chunk = task - chain * NCH; const int dir = chain & 1, h = (chain >> 1) & 7, b = chain >> 4;
        const bf16_t* DW = (const bf16_t*)(cx.p->ws + (dir ? OFF_DWB : OFF_DWF));
        bf16_t* O = (bf16_t*)(cx.p->ws + (dir ? OFF_OB : OFF_OF));
        const int hc = h * 64 + lane; const int sgn = dir ? -1 : 1;
        const float kkc = cx.p->in[I_KK][layer * 512 + hc], kac = cx.p->in[I_KA][layer * 512 + hc];
        f32x2 S[NR][8];
#pragma unroll
        for (int ii = 0; ii < NR; ++ii)
#pragma unroll
            for (int q = 0; q < 8; ++q) { const int row = rowbase + ii, col = 16 * cg + 2 * q;
                S[ii][q] = (!PB && sub == 1) ? (f32x2){row == col ? 1.f : 0.f, row == col + 1 ? 1.f : 0.f} : (f32x2){0.f, 0.f}; }
        if (PB && chunk > 0) {
            const float* src = STT + ((size_t)(chain * 16 + chunk - 1) * 2) * 4096 + rowbase * 64 + 16 * cg;
#pragma unroll
            for (int ii = 0; ii < NR; ++ii)
#pragma unroll
                for (int q = 0; q < 4; ++q) { const f32x4 v = *(const f32x4*)(src + ii * 64 + q * 4); S[ii][2 * q] = (f32x2){v[0], v[1]}; S[ii][2 * q + 1] = (f32x2){v[2], v[3]}; }
        }
        bf16_t raw[4][5];
        int R0 = tokrow(b, dir, chunk * 528);
#pragma unroll
        for (int t = 0; t < 4; ++t) { const size_t R = (size_t)(R0 + sgn * (sub * 4 + t));
            raw[t][0] = ZF[R * 1536 + hc]; raw[t][1] = ZF[R * 1536 + 512 + hc]; raw[t][2] = ZF[R * 1536 + 1024 + hc]; raw[t][3] = DW[R * 512 + hc]; raw[t][4] = DA[R * 512 + hc]; }
        for (int batch = 0; batch < 66; ++batch) {
            const int Rb0 = R0;
            LAS float* st = stg + (batch & 1) * 3072;
            float kkr[4], nrm[4];
#pragma unroll
            for (int t = 0; t < 4; ++t) {
                const float r = bf2f(raw[t][0]), k = bf2f(raw[t][1]), v = bf2f(raw[t][2]), w = bf2f(raw[t][3]), a = bf2f(raw[t][4]);
                kkr[t] = k * kkc; nrm[t] = kkr[t] * kkr[t];
                LAS float* sb = st + (sub * 4 + t) * 384;
                sb[lane] = w; sb[192 + lane] = k * (1.0f + (a - 1.0f) * kac); sb[256 + lane] = r; sb[320 + lane] = v;
            }
#pragma unroll
            for (int t = 0; t < 4; ++t) nrm[t] = row16_allsum(nrm[t]);
#pragma unroll
            for (int t = 0; t < 4; ++t) {
                const float tot = (rlf(nrm[t], 0) + rlf(nrm[t], 16)) + (rlf(nrm[t], 32) + rlf(nrm[t], 48));
                const float kk = kkr[t] * rsqrtf(tot + 1e-12f); const float a = bf2f(raw[t][4]);
                LAS float* sb = st + (sub * 4 + t) * 384; sb[64 + lane] = kk; sb[128 + lane] = kk * a;
            }
            if (batch < 65) {
                R0 = tokrow(b, dir, chunk * 528 + (batch + 1) * 8);
#pragma unroll
                for (int t = 0; t < 4; ++t) { const size_t R = (size_t)(R0 + sgn * (sub * 4 + t));
                    raw[t][0] = ZF[R * 1536 + hc]; raw[t][1] = ZF[R * 1536 + 512 + hc]; raw[t][2] = ZF[R * 1536 + 1024 + hc]; raw[t][3] = DW[R * 512 + hc]; raw[t][4] = DA[R * 512 + hc]; }
            }
            __syncthreads();
#pragma unroll 4
            for (int t = 0; t < 8; ++t) {
                const LAS float* sb = st + t * 384; float o[NR];
                if (PB) {
                    rwkv_step<NR, true, true>(S, sb, cg, rowbase, o);
                    if (cg < 2) O[(size_t)(Rb0 + sgn * t) * 512 + h * 64 + rowbase + cg] = f2bf(cg == 0 ? o[0] : o[1]);
                } else if (sub == 0) rwkv_step<NR, true, false>(S, sb, cg, rowbase, o);
                else rwkv_step<NR, false, false>(S, sb, cg, rowbase, o);
            }
        }
        if (!PB && (sub == 0 || chunk > 0)) {
            float* d0 = STT + ((size_t)(chain * 16 + chunk) * 2 + sub) * 4096 + rowbase * 64 + 16 * cg;
#pragma unroll
            for (int ii = 0; ii < NR; ++ii)
#pragma unroll
                for (int q = 0; q < 4; ++q) *(f32x4*)(d0 + ii * 64 + q * 4) = (f32x4){S[ii][2 * q][0], S[ii][2 * q][1], S[ii][2 * q + 1][0], S[ii][2 * q + 1][1]};
        }
        __syncthreads();
    }
}
__device__ __forceinline__ void phase_rwkv_prefix(const Ctx& cx, float* lds) {
    const int tid = cx.tid; float* STT = (float*)(cx.p->ws + OFF_ST);
    float* sA = lds; float* sP = lds + 16 * 65;
    for (int task = cx.bid; task < 256; task += cx.nb) {
        const int chain = task >> 2, r0 = (task & 3) * 16;
        __syncthreads();
        { const float* s0 = STT + ((size_t)(chain * 16) * 2) * 4096 + r0 * 64; for (int i = tid; i < 1024; i += 512) sA[(i >> 6) * 65 + (i & 63)] = s0[i]; }
        f32x4 pr[2];
        { const float* pm = STT + ((size_t)(chain * 16 + 1) * 2 + 1) * 4096; pr[0] = *(const f32x4*)(pm + tid * 8); pr[1] = *(const f32x4*)(pm + tid * 8 + 4); }
        const int i = tid >> 5, j0 = (tid & 31) * 2;
        for (int c = 1; c < 15; ++c) {
            float* se = STT + ((size_t)(chain * 16 + c) * 2) * 4096 + r0 * 64;
            __syncthreads();
            *(f32x4*)(sP + tid * 8) = pr[0]; *(f32x4*)(sP + tid * 8 + 4) = pr[1];
            if (c < 14) { const float* pm = STT + ((size_t)(chain * 16 + c + 1) * 2 + 1) * 4096; pr[0] = *(const f32x4*)(pm + tid * 8); pr[1] = *(const f32x4*)(pm + tid * 8 + 4); }
            float a0 = se[i * 64 + j0], a1 = se[i * 64 + j0 + 1];
            __syncthreads();
            for (int k = 0; k < 64; ++k) { const float a = sA[i * 65 + k]; a0 += a * sP[k * 64 + j0]; a1 += a * sP[k * 64 + j0 + 1]; }
            __syncthreads();
            sA[i * 65 + j0] = a0; sA[i * 65 + j0 + 1] = a1; se[i * 64 + j0] = a0; se[i * 64 + j0 + 1] = a1;
        }
    }
}
__device__ __forceinline__ void phase_rwkv_finish(const Ctx& cx, int layer) {
    const int lane = cx.tid & 63, gw = cx.bid * 8 + (cx.tid >> 6), nw = cx.nb * 8;
    const bf16_t* ZF = (const bf16_t*)(cx.p->ws + OFF_ZF); const bf16_t* DA = (const bf16_t*)(cx.p->ws + OFF_DWA); const bf16_t* G = (const bf16_t*)(cx.p->ws + OFF_G);
    const bf16_t* OF = (const bf16_t*)(cx.p->ws + OFF_OF); const bf16_t* OB = (const bf16_t*)(cx.p->ws + OFF_OB); bf16_t* YR = (bf16_t*)(cx.p->ws + OFF_YR);
    const int c0 = lane * 8;
    float ka[8], rk[8], gg[8], gb[8];
#pragma unroll
    for (int j = 0; j < 8; ++j) { ka[j] = cx.p->in[I_KA][layer * 512 + c0 + j]; rk[j] = cx.p->in[I_RK][layer * 512 + c0 + j]; gg[j] = cx.p->in[I_GNG][layer * 512 + c0 + j]; gb[j] = cx.p->in[I_GNB][layer * 512 + c0 + j]; }
    for (int r = gw; r < MT; r += nw) {
        const u32x4 of = *(const u32x4*)(OF + (size_t)r * 512 + c0), ob = *(const u32x4*)(OB + (size_t)r * 512 + c0);
        const u32x4 rr = *(const u32x4*)(ZF + (size_t)r * 1536 + c0), kk = *(const u32x4*)(ZF + (size_t)r * 1536 + 512 + c0), vv = *(const u32x4*)(ZF + (size_t)r * 1536 + 1024 + c0);
        const u32x4 aa = *(const u32x4*)(DA + (size_t)r * 512 + c0), g4 = *(const u32x4*)(G + (size_t)r * 512 + c0);
        const unsigned ofw[4] = {of.x, of.y, of.z, of.w}, obw[4] = {ob.x, ob.y, ob.z, ob.w}, rw[4] = {rr.x, rr.y, rr.z, rr.w}, kw[4] = {kk.x, kk.y, kk.z, kk.w},
                       vw[4] = {vv.x, vv.y, vv.z, vv.w}, aw[4] = {aa.x, aa.y, aa.z, aa.w}, gw4[4] = {g4.x, g4.y, g4.z, g4.w};
        float o[8], vf[8], gf[8]; float s = 0.f, bs = 0.f;
#pragma unroll
        for (int j = 0; j < 4; ++j) {
            o[2 * j] = bflo(ofw[j]) + bflo(obw[j]); o[2 * j + 1] = bfhi(ofw[j]) + bfhi(obw[j]);
            vf[2 * j] = bflo(vw[j]); vf[2 * j + 1] = bfhi(vw[j]); gf[2 * j] = bflo(gw4[j]); gf[2 * j + 1] = bfhi(gw4[j]);
            const float k0 = bflo(kw[j]) * (1.0f + (bflo(aw[j]) - 1.0f) * ka[2 * j]), k1 = bfhi(kw[j]) * (1.0f + (bfhi(aw[j]) - 1.0f) * ka[2 * j + 1]);
            bs += bflo(rw[j]) * k0 * rk[2 * j] + bfhi(rw[j]) * k1 * rk[2 * j + 1];
            s += o[2 * j] + o[2 * j + 1];
        }
        s += swz<1>(s); s += swz<2>(s); s += swz<4>(s);
        bs += swz<1>(bs); bs += swz<2>(bs); bs += swz<4>(bs);
        const float mean = s * (1.0f / 64.0f); float q = 0.f;
#pragma unroll
        for (int j = 0; j < 8; ++j) { o[j] -= mean; q += o[j] * o[j]; }
        q += swz<1>(q); q += swz<2>(q); q += swz<4>(q);
        const float rstd = rsqrtf(q * (1.0f / 64.0f) + 64e-5f);
        float y[8];
#pragma unroll
        for (int j = 0; j < 8; ++j) y[j] = (o[j] * rstd * gg[j] + gb[j] + bs * vf[j]) * gf[j];
        u32x4 w; w.x = pk2(y[0], y[1]); w.y = pk2(y[2], y[3]); w.z = pk2(y[4], y[5]); w.w = pk2(y[6], y[7]);
        *(u32x4*)(YR + (size_t)r * 512 + c0) = w;
    }
}

template <int ph> __device__ __forceinline__ void run_phase_t(const Ctx& cx, unsigned char* shm) {
    LAS unsigned char* lds = (LAS unsigned char*)shm;
    float* ldf = (float*)shm;
    char* ws = cx.p->ws; char* wb = ws + OFF_WB; float* mods = (float*)(ws + OFF_MODS);
    if (ph == 0) { phase_ada(cx, ldf); __syncthreads(); phase_cv(cx, 0, ldf); if (PROBE == 8) { __syncthreads(); phase_ada(cx, ldf); __syncthreads(); phase_cv(cx, 0, ldf); } return; }
    if (ph == 1) { phase_row<1 | 16 | 4>(cx, MT, nullptr, nullptr, mods + 0 * 1024, (bf16_t*)(ws + OFF_U)); return; }
    const int l = (ph - 2) / 16, s = (ph - 2) % 16;
    const float* lm = mods + (size_t)l * 5 * 9216;
    const float* lng = cx.p->in[I_LNG] + (size_t)l * 3 * 1024; const float* lnb = cx.p->in[I_LNB] + (size_t)l * 3 * 1024;
    const int Mlate = (l == 1) ? ML : MT;
    switch (s) {
    case 0: { EpiSwiglu E{(bf16_t*)(ws + OFF_ACT)}; run_gemm<true>(cx, lds, ws + OFF_U, 1024, wb + WB_W1A, 1024, MT, 5632, 1024, E); if (PROBE == 2) run_gemm<true>(cx, lds, ws + OFF_U, 1024, wb + WB_W1A, 1024, MT, 5632, 1024, E); } break;
    case 1: { EpiH E{(bf16_t*)(ws + OFF_H)}; run_gemm<true>(cx, lds, ws + OFF_ACT, DFF, wb + WB_W2A, DFF, MT, 1024, DFF, E); } break;
    case 2: if (l == 0) phase_row<1 | 8 | 2 | 4>(cx, MT, lng, lnb, lm + 3 * 1024, (bf16_t*)(ws + OFF_U), lm + 2 * 1024, 0.5f, (const bf16_t*)(ws + OFF_H));
            else phase_row<8 | 2 | 4>(cx, MT, lng, lnb, lm + 3 * 1024, (bf16_t*)(ws + OFF_U), lm + 2 * 1024, 0.5f, (const bf16_t*)(ws + OFF_H)); break;
    case 3: { EpiSplit E{ws}; run_gemm<true>(cx, lds, ws + OFF_U, 1024, wb + WB_WIN, 1024, MT, 3328, 1024, E); } break;
    case 4: phase_ap(cx, l); break;
    case 5: {
        if (PROBE == 7) phase_attn(cx, l, (bf16_t*)(ws + OFF_LIN));
        phase_attn(cx, l, (bf16_t*)(ws + OFF_QB));
        __syncthreads();
        phase_s5(cx, l, lds);
        __syncthreads();
        if (PROBE == 3) { phase_s5(cx, l, lds); __syncthreads(); }
        EpiLora E{ws, cx.p->in[I_W0] + (size_t)l * 1024, cx.p->in[I_A0] + (size_t)l * 512};
        run_gemm<true>(cx, lds, ws + OFF_AP, 384, wb + WB_LORA, 384, MT, 2048, 384, E);
    } break;
    case 6: phase_rwkv_scan<false>(cx, l, lds); if (PROBE == 1) phase_rwkv_scan<false>(cx, l, lds); phase_s5gelu(cx, l); break;
    case 7: {
        phase_rwkv_prefix(cx, ldf);
        __syncthreads();
        EpiGlu E{(const bf16_t*)(ws + OFF_ZS), (bf16_t*)(ws + OFF_YS), cx.p->in[I_GLUB] + (size_t)l * 512};
        run_gemm<true>(cx, lds, ws + OFF_ZS, 512, wb + WB_GLU, 512, MT, 512, 512, E);
    } break;
    case 8: phase_rwkv_scan<true>(cx, l, lds); if (PROBE == 1) phase_rwkv_scan<true>(cx, l, lds); break;
    case 9: phase_rwkv_finish(cx, l); phase_row<4>(cx, Mlate, nullptr, nullptr, lm + 3 * 1024, (bf16_t*)(ws + OFF_U2));
        if (PROBE == 5) phase_row<4>(cx, Mlate, nullptr, nullptr, lm + 3 * 1024, (bf16_t*)(ws + OFF_U2)); if (PROBE == 6) phase_rwkv_finish(cx, l); break;
    case 10: {
        const char* Y[3] = {ws + OFF_QB, ws + OFF_YR, ws + OFF_YS};
#pragma unroll
        for (int i = 0; i < 3; ++i) {
            { EpiGate E{(bf16_t*)(ws + OFF_GB)}; run_gemm<true>(cx, lds, ws + OFF_U2, 1024, wb + WB_WGT + (size_t)i * 1024 * 1024 * 2, 1024, Mlate, 1024, 1024, E); }
            { EpiBranch E{(const bf16_t*)(ws + OFF_GB), (bf16_t*)(ws + OFF_MG), i == 0}; run_gemm<true>(cx, lds, Y[i], 512, wb + WB_BP + (size_t)i * 1024 * 512 * 2, 512, Mlate, 1024, 512, E); }
        }
    } break;
    case 11: { EpiH E{(bf16_t*)(ws + OFF_H)}; run_gemm<true>(cx, lds, ws + OFF_MG, 1024, wb + WB_WOUT, 1024, Mlate, 1024, 1024, E); } break;
    case 12: phase_row<8 | 2 | 4>(cx, Mlate, lng + 1024, lnb + 1024, lm + 6 * 1024, (bf16_t*)(ws + OFF_U), lm + 5 * 1024, 1.0f, (const bf16_t*)(ws + OFF_H)); break;
    case 13: { EpiSwiglu E{(bf16_t*)(ws + OFF_ACT)}; run_gemm<true>(cx, lds, ws + OFF_U, 1024, wb + WB_W1B, 1024, Mlate, 5632, 1024, E); } break;
    case 14: { EpiH E{(bf16_t*)(ws + OFF_H)}; run_gemm<true>(cx, lds, ws + OFF_ACT, DFF, wb + WB_W2B, DFF, Mlate, 1024, DFF, E); } break;
    case 15:
        if (l == 0) { phase_row<8 | 2 | 4>(cx, MT, lng + 2048, lnb + 2048, mods + (size_t)5 * 9216, (bf16_t*)(ws + OFF_U), lm + 8 * 1024, 0.5f, (const bf16_t*)(ws + OFF_H)); __syncthreads(); phase_cv(cx, 1, ldf); }
        else phase_row<8 | 2>(cx, ML, lng + 2048, lnb + 2048, nullptr, nullptr, lm + 8 * 1024, 0.5f, (const bf16_t*)(ws + OFF_H));
        break;
    }
}


#define XB_TMO      128
#define XB_XCNT(j)  (256  + 64 * (j))
#define XB_XSUB(j)  (1280 + 64 * (j))
#define XB_XGEN(j)  (2304 + 64 * (j))
#define XB_TOP      3328
#define XB_TOPGEN   3392
#define XCD_BAR_WORDS 3456
#define XB_SPIN_CAP (1u << 18)
DI unsigned xb_ld(unsigned* p) { return __hip_atomic_load(p, __ATOMIC_RELAXED, __HIP_MEMORY_SCOPE_AGENT); }
DI unsigned xb_add(unsigned* p, unsigned v) { return __hip_atomic_fetch_add(p, v, __ATOMIC_RELAXED, __HIP_MEMORY_SCOPE_AGENT); }
DI unsigned xb_xcc_id() { return (unsigned)__builtin_amdgcn_s_getreg((3 << 11) | 20) & 0xFu; }
#define XB_SPIN(cond, bar) do { unsigned _sp = 0; while (cond) { __builtin_amdgcn_s_sleep(1); \
    if ((++_sp & 255u) == 0u) { if (xb_ld(&(bar)[XB_TMO])) break; if (_sp > XB_SPIN_CAP) { atomicAdd(&(bar)[XB_TMO], 1u); break; } } } } while (0)
struct XcdBarrier { unsigned* bar; unsigned x; volatile LAS unsigned* st; };
DI XcdBarrier xcd_barrier_post(unsigned* bar, volatile LAS unsigned* st) {
    XcdBarrier b; b.bar = bar; b.x = xb_xcc_id(); b.st = st;
    if (threadIdx.x == 0) (void)xb_add(&bar[XB_XCNT(b.x)], 1u);
    return b;
}
DI void xcd_barrier_complete(unsigned* bar, unsigned x, unsigned& nloc, unsigned& nx) {
    const unsigned G = gridDim.x * gridDim.y * gridDim.z;
    unsigned sum, cnt, mine, sp = 0u;
    for (;;) {
        sum = 0u; cnt = 0u; mine = 0u;
#pragma unroll
        for (unsigned j = 0; j < 16; ++j) { const unsigned c = xb_ld(&bar[XB_XCNT(j)]); sum += c; cnt += (c > 0u) ? 1u : 0u; mine = (j == x) ? c : mine; }
        if (sum == G) break;
        __builtin_amdgcn_s_sleep(1);
        if ((++sp & 255u) == 0u) { if (xb_ld(&bar[XB_TMO])) break; if (sp > XB_SPIN_CAP) { atomicAdd(&bar[XB_TMO], 1u); break; } }
    }
    nloc = mine > 0u ? mine : 1u; nx = cnt > 0u ? cnt : 1u;
}
DI void xcd_barrier(const XcdBarrier& b) {
    asm volatile("s_waitcnt vmcnt(0)" ::: "memory");
    __syncthreads();
    if (threadIdx.x == 0) {
        unsigned* bar = b.bar;
        __builtin_amdgcn_s_waitcnt(0);
        unsigned nloc = b.st[0], nx = b.st[1];
        if (nloc == 0u) { xcd_barrier_complete(bar, b.x, nloc, nx); b.st[0] = nloc; b.st[1] = nx; }
        const unsigned old = xb_add(&bar[XB_XSUB(b.x)], 1u);
        const unsigned gen = old / nloc;
        if (old + 1u == (gen + 1u) * nloc) {
            __builtin_amdgcn_fence(__ATOMIC_RELEASE, "agent");
            asm volatile("s_waitcnt vmcnt(0)" ::: "memory");
            const unsigned og = xb_add(&bar[XB_TOP], 1u);
            const unsigned tg = og / nx;
            if (og + 1u == (tg + 1u) * nx) xb_add(&bar[XB_TOPGEN], 1u);
            else XB_SPIN(xb_ld(&bar[XB_TOPGEN]) == tg, bar);
            __builtin_amdgcn_fence(__ATOMIC_ACQUIRE, "agent");
            xb_add(&bar[XB_XGEN(b.x)], 1u);
            asm volatile("s_waitcnt vmcnt(0)" ::: "memory");
        } else {
            XB_SPIN(xb_ld(&bar[XB_XGEN(b.x)]) == gen, bar);
            __builtin_amdgcn_fence(__ATOMIC_ACQUIRE, "agent");
            asm volatile("s_waitcnt vmcnt(0)" ::: "memory");
        }
    }
    __syncthreads();
}
DI Ctx mk_ctx() {
    Ctx cx; cx.p = (PP)__builtin_amdgcn_kernarg_segment_ptr(); cx.tid = threadIdx.x; cx.bid = blockIdx.x; cx.nb = gridDim.x;
    asm volatile("" : "+s"(cx.p), "+v"(cx.tid), "+s"(cx.bid), "+s"(cx.nb));
    return cx;
}
#define PH_RUN(N) { const Ctx cx = mk_ctx(); run_phase_t<N>(cx, shm); if (N + 1 < NPHASE) { if (N == 0 && gridDim.x > 1000000u) grid.sync(); xcd_barrier(xb);     } }
#if ONE_LAUNCH
__global__ void __launch_bounds__(512, 2) mega(Params p_) {
    extern __shared__ __attribute__((aligned(16))) unsigned char shm[];
    cg::grid_group grid = cg::this_grid();
    volatile LAS unsigned* xst = (volatile LAS unsigned*)((LAS unsigned char*)shm + 131072);
    if (threadIdx.x < 4) xst[threadIdx.x] = 0u;
    __syncthreads();
    const XcdBarrier xb = xcd_barrier_post((unsigned*)(((const Params*)&p_)->ws + OFF_BAR), xst);
    PH_RUN(0) PH_RUN(1) PH_RUN(2) PH_RUN(3) PH_RUN(4) PH_RUN(5) PH_RUN(6) PH_RUN(7) PH_RUN(8) PH_RUN(9) PH_RUN(10) PH_RUN(11)
    PH_RUN(12) PH_RUN(13) PH_RUN(14) PH_RUN(15) PH_RUN(16) PH_RUN(17) PH_RUN(18) PH_RUN(19) PH_RUN(20) PH_RUN(21) PH_RUN(22)
    PH_RUN(23) PH_RUN(24) PH_RUN(25) PH_RUN(26) PH_RUN(27) PH_RUN(28) PH_RUN(29) PH_RUN(30) PH_RUN(31) PH_RUN(32) PH_RUN(33)
}
#else
template <int PH> __global__ void __launch_bounds__(512, 2) k_ph(Params p_) {
    extern __shared__ __attribute__((aligned(16))) unsigned char shm[];
    Ctx cx; cx.p = (PP)__builtin_amdgcn_kernarg_segment_ptr(); cx.tid = threadIdx.x; cx.bid = blockIdx.x; cx.nb = gridDim.x;
    run_phase_t<PH>(cx, shm);
}
#endif
constexpr size_t kLds = 131072 + 16;
#if !ONE_LAUNCH
template <int PH> static void set_attr_all() { if constexpr (PH < NPHASE) { (void)hipFuncSetAttribute((const void*)k_ph<PH>, hipFuncAttributeMaxDynamicSharedMemorySize, (int)kLds); set_attr_all<PH + 1>(); } }
template <int PH> static void launch_all(const Params& p, hipStream_t st) { if constexpr (PH < NPHASE) { k_ph<PH><<<256, 512, kLds, st>>>(p); launch_all<PH + 1>(p, st); } }
#endif

extern "C" void kernel_launch(void* const* d_in, const int* in_sizes, int n_in, void* d_out, int out_size, void* d_ws, size_t ws_size, hipStream_t stream) {
    static int inited = 0;
    Params p{};
    for (int i = 0; i < 35; ++i) p.in[i] = (const float*)d_in[i];
    p.out = (float*)d_out; p.ws = (char*)d_ws;
#if ONE_LAUNCH
    if (!inited) { (void)hipFuncSetAttribute((const void*)mega, hipFuncAttributeMaxDynamicSharedMemorySize, (int)kLds); inited = 1; }
    (void)hipMemsetAsync((char*)d_ws + OFF_BAR, 0, XCD_BAR_WORDS * 4, stream);
    void* args[] = {&p};
    hipError_t e = hipLaunchCooperativeKernel((const void*)mega, dim3(256), dim3(512), args, kLds, stream);
    if (e != hipSuccess) fprintf(stderr, "cooperative launch failed: %s\n", hipGetErrorString(e));
#else
    if (!inited) { set_attr_all<0>(); inited = 1; }
    launch_all<0>(p, stream);
#endif
}
```
